# Optimizing an MI355X kernel written in HIP

```python
import math
import jax, jax.numpy as jnp
from jax import lax
import numpy as np

D_MODEL = 2048
BATCH = 1
SEQ = 8192
DEPTH = 1

HEAD_DIM = 64
A_Q_HEADS = 16
A_KV_HEADS = 4
A_GROUP = A_Q_HEADS // A_KV_HEADS
WINDOW = 128
B_HEADS = 16
BLOCK = 128
D_FF = ((8 * D_MODEL // 3 + 255) // 256) * 256
EPS = 1e-6

A_Q_W = A_Q_HEADS * HEAD_DIM
A_KV_W = A_KV_HEADS * HEAD_DIM
B_W = B_HEADS * HEAD_DIM
IN_SPLITS = (A_Q_W, A_KV_W, A_KV_W, B_W, B_W, B_W, D_MODEL, D_MODEL)
IN_WIDTH = sum(IN_SPLITS)
IN_OFFSETS = tuple(int(o) for o in np.cumsum(IN_SPLITS)[:-1])

kernel_name = "hybrid_swa_sink_stickbreaking_gated"


def rmsnorm(x, g):
    xf = x.astype(jnp.float32)
    inv = lax.rsqrt(jnp.mean(xf * xf, axis=-1, keepdims=True) + EPS)
    return (xf * inv * g.astype(jnp.float32)).astype(x.dtype)


def alibi_slopes(n_heads):
    h = jnp.arange(1, n_heads + 1, dtype=jnp.float32)
    return jnp.exp2(-8.0 * h / n_heads)


def sliding_window_attention(q, k, v, sinks):
    B, S = q.shape[0], q.shape[1]
    nb = S // BLOCK
    qb = q.reshape(B, nb, BLOCK, A_KV_HEADS, A_GROUP, HEAD_DIM)
    kb = k.reshape(B, nb, BLOCK, A_KV_HEADS, HEAD_DIM)
    vb = v.reshape(B, nb, BLOCK, A_KV_HEADS, HEAD_DIM)
    pad_k = jnp.zeros_like(kb[:, :1])
    pad_v = jnp.zeros_like(vb[:, :1])
    kk = jnp.concatenate([jnp.concatenate([pad_k, kb[:, :-1]], axis=1), kb], axis=2)
    vv = jnp.concatenate([jnp.concatenate([pad_v, vb[:, :-1]], axis=1), vb], axis=2)

    scale = 1.0 / math.sqrt(HEAD_DIM)
    s = jnp.einsum('bnqhgd,bnkhd->bnhgqk', qb, kk).astype(jnp.float32) * scale

    qi = jnp.arange(BLOCK)[:, None]
    ki = jnp.arange(2 * BLOCK)[None, :]
    dist = (BLOCK + qi - ki)
    blk = jnp.arange(nb)[:, None, None]
    valid = (dist >= 0) & (dist < WINDOW)
    valid = valid[None] & ((blk > 0) | (ki[None] >= BLOCK))

    slopes = alibi_slopes(A_Q_HEADS).reshape(A_KV_HEADS, A_GROUP)
    s = s - slopes[:, :, None, None] * dist.astype(jnp.float32)[None, None]
    s = jnp.where(valid[None, :, None, None], s, -jnp.inf)

    sink = sinks.astype(jnp.float32).reshape(A_KV_HEADS, A_GROUP)[None, None, :, :, None, None]
    sink = jnp.broadcast_to(sink, s.shape[:-1] + (1,))
    p = jax.nn.softmax(jnp.concatenate([s, sink], axis=-1), axis=-1)[..., :-1]
    o = jnp.einsum('bnhgqk,bnkhd->bnqhgd', p.astype(v.dtype), vv)
    return o.reshape(B, S, A_Q_W)


def stick_breaking_attention(q, k, v):
    B, S = q.shape[0], q.shape[1]
    nb = S // BLOCK
    scale = 1.0 / math.sqrt(HEAD_DIM)
    qb = q.reshape(B, nb, BLOCK, B_HEADS, HEAD_DIM).transpose(1, 0, 2, 3, 4)
    kpos = jnp.arange(S)

    def one_block(args):
        qblk, i = args
        z = jnp.einsum('bqhd,bkhd->bhqk', qblk, k).astype(jnp.float32) * scale
        tpos = i * BLOCK + jnp.arange(BLOCK)
        causal = kpos[None, :] < tpos[:, None]
        log_beta = jax.nn.log_sigmoid(z)
        log_fail = jnp.where(causal, jax.nn.log_sigmoid(-z), 0.0)
        suffix = lax.cumsum(log_fail, axis=3, reverse=True) - log_fail
        a = jnp.where(causal, jnp.exp(log_beta + suffix), 0.0)
        return jnp.einsum('bhqk,bkhd->bqhd', a.astype(v.dtype), v)

    o = lax.map(one_block, (qb, jnp.arange(nb)))
    return o.transpose(1, 0, 2, 3, 4).reshape(B, S, B_W)


def swiglu(h, w_in, w_down):
    gu = h @ w_in
    gate, up = jnp.split(gu, 2, axis=-1)
    return (jax.nn.silu(gate) * up) @ w_down


def setup_inputs(seed: int = 0) -> dict:
    key = jax.random.key(seed)
    ks = jax.random.split(key, 12)
    f32 = jnp.float32

    def w(k, shape, fan_in):
        return jax.random.normal(k, shape, f32) * (fan_in ** -0.5)

    def gain(k, shape):
        return 1.0 + 0.02 * jax.random.normal(k, shape, f32)

    return {
        "x": jax.random.normal(ks[0], (BATCH, SEQ, D_MODEL), f32),
        "norm_mix_g": gain(ks[1], (DEPTH, D_MODEL)),
        "w_in": w(ks[2], (DEPTH, D_MODEL, IN_WIDTH), D_MODEL),
        "sink_logits": 0.5 * jax.random.normal(ks[3], (DEPTH, A_Q_HEADS), f32),
        "w_branch_a": w(ks[4], (DEPTH, A_Q_W, D_MODEL), A_Q_W),
        "w_branch_b": w(ks[5], (DEPTH, B_W, D_MODEL), B_W),
        "w_out": w(ks[6], (DEPTH, D_MODEL, D_MODEL), D_MODEL),
        "norm_ffn_g": gain(ks[7], (DEPTH, D_MODEL)),
        "w_ffn_in": w(ks[8], (DEPTH, D_MODEL, 2 * D_FF), D_MODEL),
        "w_ffn_down": w(ks[9], (DEPTH, D_FF, D_MODEL), D_FF),
        "norm_final_g": gain(ks[10], (D_MODEL,)),
    }


def reference(x, norm_mix_g, w_in, sink_logits, w_branch_a, w_branch_b, w_out,
              norm_ffn_g, w_ffn_in, w_ffn_down, norm_final_g):
    B, S, _ = x.shape
    for layer in range(DEPTH):
        h = rmsnorm(x, norm_mix_g[layer])
        proj = h @ w_in[layer]
        qa, ka, va, qb, kb, vb, ga, gb = jnp.split(proj, IN_OFFSETS, axis=-1)

        ya = sliding_window_attention(
            qa.reshape(B, S, A_Q_HEADS, HEAD_DIM),
            ka.reshape(B, S, A_KV_HEADS, HEAD_DIM),
            va.reshape(B, S, A_KV_HEADS, HEAD_DIM),
            sink_logits[layer]) @ w_branch_a[layer]
        yb = stick_breaking_attention(
            qb.reshape(B, S, B_HEADS, HEAD_DIM),
            kb.reshape(B, S, B_HEADS, HEAD_DIM),
            vb.reshape(B, S, B_HEADS, HEAD_DIM)) @ w_branch_b[layer]

        merged = jax.nn.sigmoid(ga) * ya + jax.nn.sigmoid(gb) * yb
        x = x + merged @ w_out[layer]
        x = x + swiglu(rmsnorm(x, norm_ffn_g[layer]), w_ffn_in[layer], w_ffn_down[layer])
    return rmsnorm(x, norm_final_g)
```

```cpp
#include <hip/hip_runtime.h>
#include <hip/hip_cooperative_groups.h>
#include <cstdio>
#include <cstdint>
namespace cg = cooperative_groups;

#ifndef MK_N_LAUNCHES
#define MK_N_LAUNCHES 8
#endif

#define LAS __attribute__((address_space(3)))
typedef unsigned short bf16_t;
typedef short bf16x8 __attribute__((ext_vector_type(8)));
typedef short s16x4 __attribute__((ext_vector_type(4)));
typedef float f32x2 __attribute__((ext_vector_type(2)));
typedef float f32x4 __attribute__((ext_vector_type(4)));
typedef float f32x16 __attribute__((ext_vector_type(16)));
typedef unsigned u32x2 __attribute__((ext_vector_type(2)));
typedef unsigned u32x4 __attribute__((ext_vector_type(4)));
typedef __bf16 bfv2 __attribute__((ext_vector_type(2)));

constexpr int M = 8192, D = 2048, INW = 8704, FF = 5632, FF2 = 11264;
constexpr int QA_OFF = 0, KA_OFF = 1024, VA_OFF = 1280, QB_OFF = 1536, KB_OFF = 2560, VB_OFF = 3584, GA_OFF = 4608, GB_OFF = 6656;
constexpr float EPS = 1e-6f, LOG2E = 1.4426950408889634f, QSCALE = 0.125f * LOG2E;
constexpr int NPH = 8;
constexpr size_t MiB = 1u << 20;
constexpr size_t WS_WIN = 0, WS_WAB = 34 * MiB, WS_WOUT = 42 * MiB, WS_WFFN = 50 * MiB, WS_WDN = 94 * MiB;
constexpr size_t WS_XN = 116 * MiB;
constexpr size_t WS_ATT = 148 * MiB;
constexpr size_t WS_PROJ = 180 * MiB;
constexpr size_t WS_RSQ = 316 * MiB, WS_END = 317 * MiB;
constexpr int LDS_BYTES = 131072 + 1024;

__device__ __forceinline__ unsigned pk2(float lo, float hi) { f32x2 v = {lo, hi}; return __builtin_bit_cast(unsigned, __builtin_convertvector(v, bfv2)); }
__device__ __forceinline__ float bflo(unsigned w) { return __builtin_bit_cast(float, w << 16); }
__device__ __forceinline__ float bfhi(unsigned w) { return __builtin_bit_cast(float, w & 0xffff0000u); }
__device__ __forceinline__ float fsigmoid(float g) { return __builtin_amdgcn_rcpf(1.f + __builtin_amdgcn_exp2f(-g * LOG2E)); }

namespace pg8 {
constexpr int BM = 256, BK = 64, HALF = 128, HTB = HALF * BK * 2, STAGE_BYTES = 8 * HTB, NXCD = 8, WGM = 8;
__device__ __forceinline__ int lds_byte(int r, int c) { const int st = (r >> 4) * 2 + (c >> 5), rr = r & 15, cc = c & 31, ob = rr * 64 + cc * 2; return st * 1024 + (ob ^ (((ob >> 9) & 1) << 5)); }
__device__ __forceinline__ void stage_rc(int b, int& R, int& C) { const int st = b / 1024, sb = b % 1024, swz = sb ^ (((sb >> 9) & 1) << 5); R = (st >> 1) * 16 + swz / 64; C = (st & 1) * 32 + (swz % 64) / 2; }
__device__ __forceinline__ int perm32(int rho) { const int n = rho >> 4, i = rho & 15; return 8 * (i >> 2) + 4 * n + (i & 3); }

struct Unit { int pm, pn, z; };
struct Gemm { const bf16_t* A; const bf16_t* Bt; int lda, ldb, K; size_t zoffA, zoffB; };

struct StaticOrder {
    int nM, nN, nwg, G, c, nz;
    __device__ void init(int M_, int N_, int G_, int c_, int nz_) { nM = M_ / BM; nN = N_ / BM; nwg = nM * nN; G = G_; c = c_; nz = nz_; }
    __device__ bool next(int i, Unit& u) const {
        const int ti = i / nz; u.z = i - ti * nz;
        const long L = (long)ti * G + c; if (L >= nwg) return false;
        int wgid = (int)L; { const int q = nwg / NXCD, r = nwg % NXCD, xcd = wgid % NXCD, off = wgid / NXCD; wgid = (xcd < r ? xcd * (q + 1) : r * (q + 1) + (xcd - r) * q) + off; }
        const int nig = WGM * nN, gid = wgid / nig, fm = gid * WGM, gsz = (nM - fm) < WGM ? (nM - fm) : WGM;
        u.pm = fm + ((wgid % nig) % gsz); u.pn = (wgid % nig) / gsz; return true;
    }
};

#define EPI_ROW(u, ai, m) ((u).pm * 256 + (ai) * 128 + wr * 64 + (m) * 16 + fr)
#define EPI_COL(u, bj) ((u).pn * 256 + (bj) * 128 + wc * 32 + 8 * fq)

struct EpiStoreBf16 {
    bf16_t* O; int ldc;
    __device__ __forceinline__ void operator()(const f32x4 (&acc)[2][2][4][2], const Unit& u, int wr, int wc, int fr, int fq) const {
#pragma unroll
        for (int ai = 0; ai < 2; ++ai)
#pragma unroll
            for (int m = 0; m < 4; ++m) { bf16_t* rowp = O + (size_t)EPI_ROW(u, ai, m) * ldc;
#pragma unroll
                for (int bj = 0; bj < 2; ++bj) { const f32x4 v0 = acc[ai][bj][m][0], v1 = acc[ai][bj][m][1];
                    u32x4 w; w.x = pk2(v0[0], v0[1]); w.y = pk2(v0[2], v0[3]); w.z = pk2(v1[0], v1[1]); w.w = pk2(v1[2], v1[3]);
                    *(u32x4*)(rowp + EPI_COL(u, bj)) = w; } }
    }
};
struct EpiBranch {
    const bf16_t* PROJ; float* T; bf16_t* MRG;
    __device__ __forceinline__ void operator()(const f32x4 (&acc)[2][2][4][2], const Unit& u, int wr, int wc, int fr, int fq) const {
        const int goff = (u.z == 0) ? GA_OFF : GB_OFF;
#pragma unroll
        for (int ai = 0; ai < 2; ++ai)
#pragma unroll
            for (int m = 0; m < 4; ++m) { const int r = EPI_ROW(u, ai, m);
#pragma unroll
                for (int bj = 0; bj < 2; ++bj) { const int c = EPI_COL(u, bj);
                    const u32x4 gw = *(const u32x4*)(PROJ + (size_t)r * INW + goff + c);
                    f32x4 v0 = acc[ai][bj][m][0], v1 = acc[ai][bj][m][1];
                    v0[0] *= fsigmoid(bflo(gw.x)); v0[1] *= fsigmoid(bfhi(gw.x)); v0[2] *= fsigmoid(bflo(gw.y)); v0[3] *= fsigmoid(bfhi(gw.y));
                    v1[0] *= fsigmoid(bflo(gw.z)); v1[1] *= fsigmoid(bfhi(gw.z)); v1[2] *= fsigmoid(bflo(gw.w)); v1[3] *= fsigmoid(bfhi(gw.w));
                    float* tp = T + (size_t)r * D + c;
                    if (u.z == 0) { *(f32x4*)tp = v0; *(f32x4*)(tp + 4) = v1; }
                    else { v0 += *(const f32x4*)tp; v1 += *(const f32x4*)(tp + 4);
                        u32x4 w; w.x = pk2(v0[0], v0[1]); w.y = pk2(v0[2], v0[3]); w.z = pk2(v1[0], v1[1]); w.w = pk2(v1[2], v1[3]);
                        *(u32x4*)(MRG + (size_t)r * D + c) = w; } } }
    }
};
struct EpiRes1 {
    const float* x; float* x1; bf16_t* x1b; float* rsq;
    __device__ __forceinline__ void operator()(const f32x4 (&acc)[2][2][4][2], const Unit& u, int wr, int wc, int fr, int fq) const {
#pragma unroll
        for (int ai = 0; ai < 2; ++ai)
#pragma unroll
            for (int m = 0; m < 4; ++m) { const int r = EPI_ROW(u, ai, m); float ss = 0.f;
#pragma unroll
                for (int bj = 0; bj < 2; ++bj) { const int c = EPI_COL(u, bj); const size_t off = (size_t)r * D + c;
                    const f32x4 v0 = acc[ai][bj][m][0] + *(const f32x4*)(x + off), v1 = acc[ai][bj][m][1] + *(const f32x4*)(x + off + 4);
                    *(f32x4*)(x1 + off) = v0; *(f32x4*)(x1 + off + 4) = v1;
                    ss += (v0[0] * v0[0] + v0[1] * v0[1]) + (v0[2] * v0[2] + v0[3] * v0[3]) + (v1[0] * v1[0] + v1[1] * v1[1]) + (v1[2] * v1[2] + v1[3] * v1[3]);
                    u32x4 w; w.x = pk2(v0[0], v0[1]); w.y = pk2(v0[2], v0[3]); w.z = pk2(v1[0], v1[1]); w.w = pk2(v1[2], v1[3]);
                    *(u32x4*)(x1b + off) = w; }
                ss += __shfl_xor(ss, 16); ss += __shfl_xor(ss, 32);
                if (fq == 0) rsq[(size_t)r * 32 + u.pn * 4 + wc] = ss; }
    }
};
struct EpiSwiglu {
    const float* rsq; bf16_t* H;
    __device__ __forceinline__ void operator()(const f32x4 (&acc)[2][2][4][2], const Unit& u, int wr, int wc, int fr, int fq) const {
#pragma unroll
        for (int ai = 0; ai < 2; ++ai)
#pragma unroll
            for (int m = 0; m < 4; ++m) { const int r = EPI_ROW(u, ai, m);
                const f32x4 p0 = *(const f32x4*)(rsq + (size_t)r * 32 + 8 * fq), p1 = *(const f32x4*)(rsq + (size_t)r * 32 + 8 * fq + 4);
                float s = ((p0[0] + p0[1]) + (p0[2] + p0[3])) + ((p1[0] + p1[1]) + (p1[2] + p1[3]));
                s += __shfl_xor(s, 16); s += __shfl_xor(s, 32);
                const float inv = rsqrtf(s * (1.0f / D) + EPS);
                float h[8];
#pragma unroll
                for (int n = 0; n < 2; ++n)
#pragma unroll
                    for (int j = 0; j < 4; ++j) { const float g = acc[ai][0][m][n][j] * inv, up = acc[ai][1][m][n][j] * inv; h[4 * n + j] = g * fsigmoid(g) * up; }
                u32x4 w; w.x = pk2(h[0], h[1]); w.y = pk2(h[2], h[3]); w.z = pk2(h[4], h[5]); w.w = pk2(h[6], h[7]);
                *(u32x4*)(H + (size_t)r * FF + u.pn * 128 + wc * 32 + 8 * fq) = w; }
    }
};
struct EpiRes2 {
    float* x;
    __device__ __forceinline__ void operator()(const f32x4 (&acc)[2][2][4][2], const Unit& u, int wr, int wc, int fr, int fq) const {
#pragma unroll
        for (int ai = 0; ai < 2; ++ai)
#pragma unroll
            for (int m = 0; m < 4; ++m) { const int r = EPI_ROW(u, ai, m);
#pragma unroll
                for (int bj = 0; bj < 2; ++bj) { float* p = x + (size_t)r * D + EPI_COL(u, bj);
                    const f32x4 v0 = acc[ai][bj][m][0] + *(const f32x4*)p, v1 = acc[ai][bj][m][1] + *(const f32x4*)(p + 4);
                    *(f32x4*)p = v0; *(f32x4*)(p + 4) = v1; } }
    }
};

template <class Epi, bool ALIGN_EPI>
__device__ __forceinline__ void gemm_phase(LAS unsigned char* lds, const Gemm g, const StaticOrder& S, const Epi& E) {
    const int tid = threadIdx.x, wid = __builtin_amdgcn_readfirstlane(tid >> 6), lane = tid & 63, wr = wid >> 2, wc = wid & 3, fr = lane & 15, fq = lane >> 4;
    const int nt = g.K / BK;
    unsigned voffA[2], voffB[2];
#pragma unroll
    for (int i = 0; i < 2; ++i) { int R, C; stage_rc(tid * 16 + i * 8192, R, C); const int Rb = (R & ~31) + perm32(R & 31);
        voffA[i] = (unsigned)(R * g.lda + C) * 2u; voffB[i] = (unsigned)(Rb * g.ldb + C) * 2u; }
    const size_t kstep = (size_t)(BK * 2);
    const size_t hA = (size_t)HALF * g.lda * 2, hB = (size_t)HALF * g.ldb * 2;
    const size_t tA = 2 * hA, tB = 2 * hB;
    const unsigned ldsw = (unsigned)wid * 1024u;
    const int aoff = lds_byte(wr * 64 + fr, fq * 8), boff = lds_byte(wc * 32 + fr, fq * 8);
#define PG8_SA(b, h) (((b) * 2 + (h)) * HTB)
#define PG8_SB(b, h) ((4 + (b) * 2 + (h)) * HTB)
#define PG8_STAGE(bufoff, gbase, voff) do { _Pragma("unroll") for (int _i = 0; _i < 2; ++_i) \
        __builtin_amdgcn_global_load_lds((const unsigned*)((const char*)(gbase) + (voff)[_i]), (LAS unsigned*)(lds + (bufoff) + ldsw + _i * 8192), 16, 0, 0); } while (0)
#define PG8_LDA(dst, b, h) do { _Pragma("unroll") for (int m = 0; m < 4; ++m) _Pragma("unroll") for (int k = 0; k < 2; ++k) dst[m][k] = *(const LAS bf16x8*)(lds + PG8_SA(b, h) + aoff + m * 2048 + k * 1024); } while (0)
#define PG8_LDB(dst, b, h) do { _Pragma("unroll") for (int n = 0; n < 2; ++n) _Pragma("unroll") for (int k = 0; k < 2; ++k) dst[n][k] = *(const LAS bf16x8*)(lds + PG8_SB(b, h) + boff + n * 2048 + k * 1024); } while (0)
#define PG8_MMA(ai, bj, At, Bt) do { __builtin_amdgcn_s_setprio(1); _Pragma("unroll") for (int m = 0; m < 4; ++m) _Pragma("unroll") for (int n = 0; n < 2; ++n) _Pragma("unroll") for (int k = 0; k < 2; ++k) \
        acc[ai][bj][m][n] = __builtin_amdgcn_mfma_f32_16x16x32_bf16(Bt[n][k], At[m][k], acc[ai][bj][m][n], 0, 0, 0); __builtin_amdgcn_s_setprio(0); } while (0)
#define PG8_WAIT_V(n) asm volatile("s_waitcnt vmcnt(" #n ")" ::: "memory")
#define PG8_WAIT_L(n) asm volatile("s_waitcnt lgkmcnt(" #n ")" ::: "memory")
#define PG8_BAR __builtin_amdgcn_s_barrier()
#define PG8_SCHED __builtin_amdgcn_sched_barrier(0)
    Unit cur, nxt; int ui = 0;
    if (!S.next(0, cur)) return;
    f32x4 acc[2][2][4][2];
#pragma unroll
    for (int a = 0; a < 2; ++a)
#pragma unroll
        for (int b = 0; b < 2; ++b)
#pragma unroll
            for (int m = 0; m < 4; ++m)
#pragma unroll
                for (int n = 0; n < 2; ++n) acc[a][b][m][n] = (f32x4){0.f, 0.f, 0.f, 0.f};
    bf16x8 At[4][2], B0[2][2], B1[2][2];
    const char* cA = (const char*)g.A + (size_t)cur.pm * tA + (size_t)cur.z * g.zoffA; const char* cB = (const char*)g.Bt + (size_t)cur.pn * tB + (size_t)cur.z * g.zoffB;
    PG8_STAGE(PG8_SB(0, 0), cB, voffB); PG8_STAGE(PG8_SB(0, 1), cB + hB, voffB); PG8_STAGE(PG8_SA(0, 0), cA, voffA); PG8_STAGE(PG8_SA(0, 1), cA + hA, voffA);
    if (wr == 1) PG8_BAR;
    PG8_WAIT_V(2); PG8_BAR;
    PG8_STAGE(PG8_SB(1, 0), cB + kstep, voffB); PG8_STAGE(PG8_SA(1, 0), cA + kstep, voffA); PG8_STAGE(PG8_SB(1, 1), cB + hB + kstep, voffB);
    PG8_WAIT_V(6); PG8_BAR;
    for (;;) {
        const bool has_next = S.next(ui + 1, nxt);
        const char* nA = has_next ? (const char*)g.A + (size_t)nxt.pm * tA + (size_t)nxt.z * g.zoffA : cA; const char* nB = has_next ? (const char*)g.Bt + (size_t)nxt.pn * tB + (size_t)nxt.z * g.zoffB : cB;
        for (int t = 0; t < nt; t += 2) {
            const bool last = (t == nt - 2);
            const char* a1 = cA + (size_t)(t + 1) * kstep;
            const char* a2 = last ? nA : cA + (size_t)(t + 2) * kstep; const char* b2 = last ? nB : cB + (size_t)(t + 2) * kstep;
            const char* a3 = a2 + kstep; const char* b3 = b2 + kstep;
            PG8_LDB(B0, 0, 0); PG8_LDB(B1, 0, 1); PG8_SCHED; PG8_LDA(At, 0, 0); PG8_STAGE(PG8_SA(1, 1), a1 + hA, voffA);
            PG8_WAIT_V(8); PG8_WAIT_L(0); PG8_BAR; PG8_MMA(0, 0, At, B0); PG8_MMA(0, 1, At, B1); PG8_BAR; PG8_SCHED;
            PG8_LDA(At, 0, 1); PG8_STAGE(PG8_SB(0, 0), b2, voffB); PG8_STAGE(PG8_SB(0, 1), b2 + hB, voffB); PG8_STAGE(PG8_SA(0, 0), a2, voffA);
            PG8_WAIT_V(8); PG8_WAIT_L(0); PG8_BAR; PG8_MMA(1, 0, At, B0); PG8_MMA(1, 1, At, B1); PG8_BAR; PG8_SCHED;
            PG8_LDB(B0, 1, 0); PG8_LDB(B1, 1, 1); PG8_SCHED; PG8_LDA(At, 1, 0); PG8_STAGE(PG8_SA(0, 1), a2 + hA, voffA);
            PG8_WAIT_V(8); PG8_WAIT_L(0); PG8_BAR; PG8_MMA(0, 0, At, B0); PG8_MMA(0, 1, At, B1); PG8_BAR; PG8_SCHED;
            PG8_LDA(At, 1, 1); PG8_STAGE(PG8_SB(1, 0), b3, voffB); PG8_STAGE(PG8_SB(1, 1), b3 + hB, voffB); PG8_STAGE(PG8_SA(1, 0), a3, voffA);
            PG8_WAIT_V(8); PG8_WAIT_L(0); PG8_BAR; PG8_MMA(1, 0, At, B0); PG8_MMA(1, 1, At, B1); PG8_BAR; PG8_SCHED;
        }
        if constexpr (ALIGN_EPI) { if (wr == 0) PG8_BAR; }
        E(acc, cur, wr, wc, fr, fq);
        if (!has_next) break;
#pragma unroll
        for (int a = 0; a < 2; ++a)
#pragma unroll
            for (int b = 0; b < 2; ++b)
#pragma unroll
                for (int m = 0; m < 4; ++m)
#pragma unroll
                    for (int n = 0; n < 2; ++n) acc[a][b][m][n] = (f32x4){0.f, 0.f, 0.f, 0.f};
        cur = nxt; cA = nA; cB = nB; ++ui;
        if constexpr (ALIGN_EPI) { if (wr == 1) PG8_BAR; }
    }
    PG8_WAIT_V(0);
    if constexpr (!ALIGN_EPI) { if (wr == 0) PG8_BAR; }
    PG8_BAR;
#undef PG8_SA
#undef PG8_SB
#undef PG8_STAGE
#undef PG8_LDA
#undef PG8_LDB
#undef PG8_MMA
#undef PG8_WAIT_V
#undef PG8_WAIT_L
#undef PG8_BAR
#undef PG8_SCHED
}
}

#define MFMA32(a, b, c) __builtin_amdgcn_mfma_f32_32x32x16_bf16((a), (b), (c), 0, 0, 0)
constexpr int VT_PITCH = 72;
constexpr float SB_EXIT = -150.0f;

__device__ __forceinline__ void load_kv(const bf16_t* kp, const bf16_t* vp, bf16x8 (&Ak)[4], bf16x8 (&Vr)[4]) {
#pragma unroll
    for (int kk = 0; kk < 4; ++kk) { Ak[kk] = *(const bf16x8*)(kp + 16 * kk); Vr[kk] = *(const bf16x8*)(vp + 16 * kk); }
}
__device__ __forceinline__ void v_to_lds(LAS unsigned char* vt, const bf16x8 (&Vr)[4], int q, int hi) {
#pragma unroll
    for (int kk = 0; kk < 4; ++kk)
#pragma unroll
        for (int j = 0; j < 8; ++j) *(LAS bf16_t*)(vt + (16 * kk + 8 * hi + j) * VT_PITCH + 2 * q) = (bf16_t)Vr[kk][j];
}
__device__ __forceinline__ void pv_acc(const LAS unsigned char* vt, const bf16x8 (&P)[2], f32x16& O0, f32x16& O1, int q, int hi) {
#pragma unroll
    for (int c = 0; c < 2; ++c) {
        const LAS unsigned char* p0 = vt + q * VT_PITCH + (16 * c + 4 * hi) * 2;
        const LAS unsigned char* p1 = p0 + 32 * VT_PITCH;
        const s16x4 a0 = *(const LAS s16x4*)p0, a1 = *(const LAS s16x4*)(p0 + 16);
        const s16x4 b0 = *(const LAS s16x4*)p1, b1 = *(const LAS s16x4*)(p1 + 16);
        const bf16x8 A0 = {a0[0], a0[1], a0[2], a0[3], a1[0], a1[1], a1[2], a1[3]};
        const bf16x8 A1 = {b0[0], b0[1], b0[2], b0[3], b1[0], b1[1], b1[2], b1[3]};
        O0 = MFMA32(A0, P[c], O0); O1 = MFMA32(A1, P[c], O1);
    }
}
__device__ __forceinline__ void pack_p(const float (&a)[16], bf16x8 (&P)[2]) {
#pragma unroll
    for (int c = 0; c < 2; ++c) { u32x4 w; w.x = pk2(a[8 * c], a[8 * c + 1]); w.y = pk2(a[8 * c + 2], a[8 * c + 3]); w.z = pk2(a[8 * c + 4], a[8 * c + 5]); w.w = pk2(a[8 * c + 6], a[8 * c + 7]);
        P[c] = __builtin_bit_cast(bf16x8, w); }
}
__device__ __forceinline__ void store_o(bf16_t* orow  , const f32x16& O0, const f32x16& O1, float sc) {
#pragma unroll
    for (int g = 0; g < 4; ++g) { u32x2 w; w.x = pk2(O0[4 * g] * sc, O0[4 * g + 1] * sc); w.y = pk2(O0[4 * g + 2] * sc, O0[4 * g + 3] * sc); *(u32x2*)(orow + 8 * g) = w; }
#pragma unroll
    for (int g = 0; g < 4; ++g) { u32x2 w; w.x = pk2(O1[4 * g] * sc, O1[4 * g + 1] * sc); w.y = pk2(O1[4 * g + 2] * sc, O1[4 * g + 3] * sc); *(u32x2*)(orow + 32 + 8 * g) = w; }
}

template <bool DIAG>
__device__ __forceinline__ void sb_tile(const f32x16& S, int q, int hi, float& carry, bf16x8 (&P)[2]) {
    float sp[16], lf[16], a[16];
#pragma unroll
    for (int i = 0; i < 16; ++i) {
        const float y = S[i];
        sp[i] = fmaxf(y, 0.f) + __builtin_amdgcn_logf(1.f + __builtin_amdgcn_exp2f(-fabsf(y)));
        const int key = 8 * (i >> 2) + 4 * hi + (i & 3);
        lf[i] = (DIAG && !(key < q)) ? 0.f : -sp[i];
    }
    float g[4], pg[4];
#pragma unroll
    for (int gi = 0; gi < 4; ++gi) { g[gi] = (lf[4 * gi] + lf[4 * gi + 1]) + (lf[4 * gi + 2] + lf[4 * gi + 3]); pg[gi] = __shfl_xor(g[gi], 32); }
    float above = carry;
#pragma unroll
    for (int gi = 3; gi >= 0; --gi) {
        const float s3 = above + (hi == 0 ? pg[gi] : 0.f);
        const float s2 = s3 + lf[4 * gi + 3], s1 = s2 + lf[4 * gi + 2], s0 = s1 + lf[4 * gi + 1];
        a[4 * gi + 3] = __builtin_amdgcn_exp2f((S[4 * gi + 3] - sp[4 * gi + 3]) + s3);
        a[4 * gi + 2] = __builtin_amdgcn_exp2f((S[4 * gi + 2] - sp[4 * gi + 2]) + s2);
        a[4 * gi + 1] = __builtin_amdgcn_exp2f((S[4 * gi + 1] - sp[4 * gi + 1]) + s1);
        a[4 * gi + 0] = __builtin_amdgcn_exp2f((S[4 * gi + 0] - sp[4 * gi + 0]) + s0);
        above += g[gi] + pg[gi];
    }
    carry = above;
    if (DIAG) {
#pragma unroll
        for (int i = 0; i < 16; ++i) { const int key = 8 * (i >> 2) + 4 * hi + (i & 3); a[i] = (key < q) ? a[i] : 0.f; }
    }
    pack_p(a, P);
}

__device__ __forceinline__ void attn_b_unit(const bf16_t* PROJ, bf16_t* ATT, LAS unsigned char* vt, int h, int qt, int lane) {
    const int q = lane & 31, hi = lane >> 5, t0 = qt * 32;
    bf16x8 Bq[4];
    { const bf16_t* qp = PROJ + (size_t)(t0 + q) * INW + QB_OFF + h * 64 + 8 * hi;
#pragma unroll
      for (int kk = 0; kk < 4; ++kk) Bq[kk] = *(const bf16x8*)(qp + 16 * kk); }
    f32x16 O0, O1;
#pragma unroll
    for (int i = 0; i < 16; ++i) { O0[i] = 0.f; O1[i] = 0.f; }
    float carry = 0.f;
    const bf16_t* kvbase = PROJ + (size_t)q * INW + h * 64 + 8 * hi;
    bf16x8 Ak[4], Vr[4], P[2];
    load_kv(kvbase + (size_t)t0 * INW + KB_OFF, kvbase + (size_t)t0 * INW + VB_OFF, Ak, Vr);
    bool first = true;
    for (int s0 = t0;;) {
        f32x16 S;
#pragma unroll
        for (int i = 0; i < 16; ++i) S[i] = 0.f;
#pragma unroll
        for (int kk = 0; kk < 4; ++kk) S = MFMA32(Ak[kk], Bq[kk], S);
        v_to_lds(vt, Vr, q, hi);
        const int sn = s0 - 32; const bool more = sn >= 0;
        if (more) load_kv(kvbase + (size_t)sn * INW + KB_OFF, kvbase + (size_t)sn * INW + VB_OFF, Ak, Vr);
        if (first) sb_tile<true>(S, q, hi, carry, P); else sb_tile<false>(S, q, hi, carry, P);
        first = false;
        pv_acc(vt, P, O0, O1, q, hi);
        if (!more || __all(carry < SB_EXIT)) break;
        s0 = sn;
    }
    store_o(ATT + (size_t)(t0 + q) * D + 1024 + h * 64 + 4 * hi, O0, O1, 1.f);
}

__device__ __forceinline__ void attn_a_unit(const bf16_t* PROJ, bf16_t* ATT, LAS unsigned char* vt, int h, int qt, int lane, float sink2, float slope2) {
    const int q = lane & 31, hi = lane >> 5, t0 = qt * 32, kvh = h >> 2;
    bf16x8 Bq[4];
    { const bf16_t* qp = PROJ + (size_t)(t0 + q) * INW + QA_OFF + h * 64 + 8 * hi;
#pragma unroll
      for (int kk = 0; kk < 4; ++kk) Bq[kk] = *(const bf16x8*)(qp + 16 * kk); }
    f32x16 O0, O1;
#pragma unroll
    for (int i = 0; i < 16; ++i) { O0[i] = 0.f; O1[i] = 0.f; }
    float mrun = sink2, lrun = 1.f;
    const bf16_t* kvbase = PROJ + (size_t)q * INW + kvh * 64 + 8 * hi;
    bf16x8 Ak[4], Vr[4], P[2];
    int s0 = t0 - 128 < 0 ? 0 : t0 - 128;
    load_kv(kvbase + (size_t)s0 * INW + KA_OFF, kvbase + (size_t)s0 * INW + VA_OFF, Ak, Vr);
    for (;;) {
        f32x16 S;
#pragma unroll
        for (int i = 0; i < 16; ++i) S[i] = 0.f;
#pragma unroll
        for (int kk = 0; kk < 4; ++kk) S = MFMA32(Ak[kk], Bq[kk], S);
        v_to_lds(vt, Vr, q, hi);
        const int sn = s0 + 32; const bool more = sn <= t0;
        if (more) load_kv(kvbase + (size_t)sn * INW + KA_OFF, kvbase + (size_t)sn * INW + VA_OFF, Ak, Vr);
        const int dq = t0 - s0 + q;
        float s[16]; float mx = -INFINITY;
#pragma unroll
        for (int i = 0; i < 16; ++i) { const int dist = dq - (8 * (i >> 2) + 4 * hi + (i & 3));
            s[i] = ((unsigned)dist < 128u) ? S[i] - slope2 * (float)dist : -INFINITY; mx = fmaxf(mx, s[i]); }
        mx = fmaxf(mx, __shfl_xor(mx, 32));
        const float mnew = fmaxf(mrun, mx), alpha = __builtin_amdgcn_exp2f(mrun - mnew);
        float a[16]; float rs = 0.f;
#pragma unroll
        for (int i = 0; i < 16; ++i) { a[i] = __builtin_amdgcn_exp2f(s[i] - mnew); rs += a[i]; }
        rs += __shfl_xor(rs, 32);
        lrun = lrun * alpha + rs; mrun = mnew;
#pragma unroll
        for (int i = 0; i < 16; ++i) { O0[i] *= alpha; O1[i] *= alpha; }
        pack_p(a, P);
        pv_acc(vt, P, O0, O1, q, hi);
        if (!more) break;
        s0 = sn;
    }
    store_o(ATT + (size_t)(t0 + q) * D + h * 64 + 4 * hi, O0, O1, 1.f / lrun);
}

__device__ __forceinline__ float wave_sum(float v) {
#pragma unroll
    for (int o = 1; o < 64; o <<= 1) v += __shfl_xor(v, o);
    return v;
}
__device__ __forceinline__ void p0_transpose_item(const float* W, int N, bf16_t* WT, int ldT, int out_row0, int k0, int n0, float cscale, const float* kscale, LAS float* scr, int lane) {
#pragma unroll 8
    for (int i = 0; i < 32; ++i) { const int kk = 2 * i + (lane >> 5); float w = W[(size_t)(k0 + kk) * N + n0 + (lane & 31)] * cscale; if (kscale) w *= kscale[k0 + kk]; scr[kk * 33 + (lane & 31)] = w; }
    asm volatile("s_waitcnt lgkmcnt(0)" ::: "memory");
    const int c = lane & 7;
#pragma unroll
    for (int j = 0; j < 4; ++j) { const int n = (lane >> 3) + 8 * j; const LAS float* s = scr + (8 * c) * 33 + n;
        u32x4 o; o.x = pk2(s[0 * 33], s[1 * 33]); o.y = pk2(s[2 * 33], s[3 * 33]); o.z = pk2(s[4 * 33], s[5 * 33]); o.w = pk2(s[6 * 33], s[7 * 33]);
        *(u32x4*)(WT + (size_t)(out_row0 + n) * ldT + k0 + 8 * c) = o; }
    asm volatile("s_waitcnt lgkmcnt(0)" ::: "memory");
}

struct Args { const float* in[11]; float* out; unsigned char* ws; int ph_lo, ph_hi; };

__global__ void __launch_bounds__(512, 2) fwd_megakernel(Args args) {
    extern __shared__ __attribute__((aligned(16))) unsigned char lds_raw[];
    LAS unsigned char* lds = (LAS unsigned char*)lds_raw;
    cg::grid_group grid = cg::this_grid();
    const int tid = threadIdx.x, lane = tid & 63, wave = __builtin_amdgcn_readfirstlane(tid >> 6);
    const int G = gridDim.x, gw = blockIdx.x * 8 + wave, NGW = G * 8;
    const int lo = args.ph_lo, hi = args.ph_hi;
    unsigned char* ws = args.ws;
    const float* x = args.in[0]; const float* g_mix = args.in[1]; const float* w_in = args.in[2]; const float* sinks = args.in[3];
    const float* w_a = args.in[4]; const float* w_b = args.in[5]; const float* w_out = args.in[6]; const float* g_ffn = args.in[7];
    const float* w_ffn = args.in[8]; const float* w_dn = args.in[9]; const float* g_fin = args.in[10];
    float* out = args.out;
    bf16_t* Win_t = (bf16_t*)(ws + WS_WIN); bf16_t* Wab_t = (bf16_t*)(ws + WS_WAB); bf16_t* Wout_t = (bf16_t*)(ws + WS_WOUT);
    bf16_t* Wffn_t = (bf16_t*)(ws + WS_WFFN); bf16_t* Wdn_t = (bf16_t*)(ws + WS_WDN);
    bf16_t* XN = (bf16_t*)(ws + WS_XN); bf16_t* MRG = XN; bf16_t* ATT = (bf16_t*)(ws + WS_ATT); bf16_t* X1B = ATT;
    bf16_t* PROJ = (bf16_t*)(ws + WS_PROJ); bf16_t* H = PROJ; float* RSQ = (float*)(ws + WS_RSQ);
#define IN(k) (lo <= (k) && (k) < hi)
#define SEAM(k) do { if (IN(k) && IN((k) + 1)) grid.sync(); } while (0)

    if (IN(0)) {
        LAS float* scr = (LAS float*)(lds + wave * 16384);
        constexpr int I_IN = (D / 64) * (INW / 32), I_AB = (1024 / 64) * (D / 32), I_OUT = (D / 64) * (D / 32), I_FFN = (D / 64) * (FF2 / 32), I_DN = (FF / 64) * (D / 32);
        constexpr int NITEMS = I_IN + 2 * I_AB + I_OUT + I_FFN + I_DN;
        for (int it = gw; it < NITEMS; it += NGW) {
            int r = it;
            if (r < I_IN) { const int nb = INW / 32, kb = r / nb, n0 = (r % nb) * 32; const float cs = (n0 < 1024 || (n0 >= QB_OFF && n0 < KB_OFF)) ? QSCALE : 1.f;
                p0_transpose_item(w_in, INW, Win_t, D, n0, kb * 64, n0, cs, nullptr, scr, lane); continue; } r -= I_IN;
            if (r < I_AB) { const int nb = D / 32, kb = r / nb, n0 = (r % nb) * 32; p0_transpose_item(w_a, D, Wab_t, 1024, n0, kb * 64, n0, 1.f, nullptr, scr, lane); continue; } r -= I_AB;
            if (r < I_AB) { const int nb = D / 32, kb = r / nb, n0 = (r % nb) * 32; p0_transpose_item(w_b, D, Wab_t + (size_t)D * 1024, 1024, n0, kb * 64, n0, 1.f, nullptr, scr, lane); continue; } r -= I_AB;
            if (r < I_OUT) { const int nb = D / 32, kb = r / nb, n0 = (r % nb) * 32; p0_transpose_item(w_out, D, Wout_t, D, n0, kb * 64, n0, 1.f, nullptr, scr, lane); continue; } r -= I_OUT;
            if (r < I_FFN) { const int nb = FF2 / 32, kb = r / nb, n0 = (r % nb) * 32; const int up = n0 >= FF, nn = up ? n0 - FF : n0;
                p0_transpose_item(w_ffn, FF2, Wffn_t, D, (nn >> 7) * 256 + up * 128 + (nn & 127), kb * 64, n0, 1.f, g_ffn, scr, lane); continue; } r -= I_FFN;
            { const int nb = D / 32, kb = r / nb, n0 = (r % nb) * 32; p0_transpose_item(w_dn, D, Wdn_t, FF, n0, kb * 64, n0, 1.f, nullptr, scr, lane); }
        }
        for (int m = gw; m < M; m += NGW) {
            const f32x4* xr = (const f32x4*)(x + (size_t)m * D) + lane; const f32x4* gr = (const f32x4*)g_mix + lane;
            f32x4 v[8]; float s = 0.f;
#pragma unroll
            for (int j = 0; j < 8; ++j) { v[j] = xr[64 * j]; s += (v[j][0] * v[j][0] + v[j][1] * v[j][1]) + (v[j][2] * v[j][2] + v[j][3] * v[j][3]); }
            const float inv = rsqrtf(wave_sum(s) * (1.f / D) + EPS);
            u32x2* o = (u32x2*)(XN + (size_t)m * D) + lane;
#pragma unroll
            for (int j = 0; j < 8; ++j) { const f32x4 gg = gr[64 * j]; u32x2 w; w.x = pk2(v[j][0] * inv * gg[0], v[j][1] * inv * gg[1]); w.y = pk2(v[j][2] * inv * gg[2], v[j][3] * inv * gg[3]); o[64 * j] = w; }
        }
    }
    SEAM(0);
    if (IN(1)) {
        pg8::Gemm g{XN, Win_t, D, D, D, 0, 0}; pg8::StaticOrder S; S.init(M, INW, G, (int)blockIdx.x, 1);
        pg8::EpiStoreBf16 E{PROJ, INW};
        pg8::gemm_phase<pg8::EpiStoreBf16, true>(lds, g, S, E);
    }
    SEAM(1);
    if (IN(2)) {
        LAS unsigned char* vt = lds + wave * 8192;
        for (int u = gw; u < 4096; u += NGW) attn_b_unit(PROJ, ATT, vt, u >> 8, u & 255, lane);
        for (int u = gw; u < 4096; u += NGW) { const int h = u >> 8;
            attn_a_unit(PROJ, ATT, vt, h, u & 255, lane, sinks[h] * LOG2E, __builtin_amdgcn_exp2f(-0.5f * (float)(h + 1)) * LOG2E); }
        __syncthreads();
    }
    SEAM(2);
    if (IN(3)) {
        pg8::Gemm g{ATT, Wab_t, D, 1024, 1024, (size_t)1024 * 2, (size_t)D * 1024 * 2}; pg8::StaticOrder S; S.init(M, D, G, (int)blockIdx.x, 2);
        pg8::EpiBranch E{PROJ, out, MRG};
        pg8::gemm_phase<pg8::EpiBranch, true>(lds, g, S, E);
    }
    SEAM(3);
    if (IN(4)) {
        pg8::Gemm g{MRG, Wout_t, D, D, D, 0, 0}; pg8::StaticOrder S; S.init(M, D, G, (int)blockIdx.x, 1);
        pg8::EpiRes1 E{x, out, X1B, RSQ};
        pg8::gemm_phase<pg8::EpiRes1, false>(lds, g, S, E);
    }
    SEAM(4);
    if (IN(5)) {
        pg8::Gemm g{X1B, Wffn_t, D, D, D, 0, 0}; pg8::StaticOrder S; S.init(M, FF2, G, (int)blockIdx.x, 1);
        pg8::EpiSwiglu E{RSQ, H};
        pg8::gemm_phase<pg8::EpiSwiglu, true>(lds, g, S, E);
    }
    SEAM(5);
    if (IN(6)) {
        pg8::Gemm g{H, Wdn_t, FF, FF, FF, 0, 0}; pg8::StaticOrder S; S.init(M, D, G, (int)blockIdx.x, 1);
        pg8::EpiRes2 E{out};
        pg8::gemm_phase<pg8::EpiRes2, false>(lds, g, S, E);
    }
    SEAM(6);
    if (IN(7)) {
        for (int m = gw; m < M; m += NGW) {
            f32x4* xr = (f32x4*)(out + (size_t)m * D) + lane; const f32x4* gr = (const f32x4*)g_fin + lane;
            f32x4 v[8]; float s = 0.f;
#pragma unroll
            for (int j = 0; j < 8; ++j) { v[j] = xr[64 * j]; s += (v[j][0] * v[j][0] + v[j][1] * v[j][1]) + (v[j][2] * v[j][2] + v[j][3] * v[j][3]); }
            const float inv = rsqrtf(wave_sum(s) * (1.f / D) + EPS);
#pragma unroll
            for (int j = 0; j < 8; ++j) { const f32x4 gg = gr[64 * j]; xr[64 * j] = v[j] * inv * gg; }
        }
    }
#undef IN
#undef SEAM
}

extern "C" void kernel_launch(void* const* d_in, const int* in_sizes, int n_in, void* d_out, int out_size, void* d_ws, size_t ws_size, hipStream_t stream) {
    static int grid = 0;
    if (grid == 0) {
        if (n_in != 11 || in_sizes[0] != M * D || out_size != M * D || ws_size < WS_END) { fprintf(stderr, "kernel_launch: unexpected sizes (n_in %d, in0 %d, out %d, ws %zu)\n", n_in, n_in > 0 ? in_sizes[0] : -1, out_size, ws_size); grid = -1; return; }
        int dev = 0, cus = 0, per_cu = 0;
        if (hipGetDevice(&dev) != hipSuccess || hipDeviceGetAttribute(&cus, hipDeviceAttributeMultiprocessorCount, dev) != hipSuccess) { grid = -1; return; }
        if (hipFuncSetAttribute((const void*)fwd_megakernel, hipFuncAttributeMaxDynamicSharedMemorySize, LDS_BYTES) != hipSuccess) { fprintf(stderr, "kernel_launch: hipFuncSetAttribute failed\n"); grid = -1; return; }
        if (hipOccupancyMaxActiveBlocksPerMultiprocessor(&per_cu, (const void*)fwd_megakernel, 512, LDS_BYTES) != hipSuccess || per_cu < 1) { fprintf(stderr, "kernel_launch: occupancy query says %d\n", per_cu); per_cu = 1; }
        (void)hipGetLastError();
        grid = cus * 1;
    }
    if (grid < 0) return;
    Args a{};
    for (int i = 0; i < 11; ++i) a.in[i] = (const float*)d_in[i];
    a.out = (float*)d_out; a.ws = (unsigned char*)d_ws;
#if MK_N_LAUNCHES == 1
    a.ph_lo = 0; a.ph_hi = NPH;
    void* kargs[] = {&a};
    hipError_t e = hipLaunchCooperativeKernel((const void*)fwd_megakernel, dim3(grid), dim3(512), kargs, LDS_BYTES, stream);
    if (e != hipSuccess) fprintf(stderr, "kernel_launch: cooperative launch failed: %s (grid %d)\n", hipGetErrorString(e), grid);
#else
    for (int p = 0; p < NPH; ++p) {
        a.ph_lo = p; a.ph_hi = p + 1;
        hipLaunchKernelGGL(fwd_megakernel, dim3(grid), dim3(512), LDS_BYTES, stream, a);
    }
#endif
}
```

```cpp
#include <hip/hip_runtime.h>
#include <hip/hip_cooperative_groups.h>
#include <cstdio>
#include <cstdint>
namespace cg = cooperative_groups;

#ifndef MK_N_LAUNCHES
#define MK_N_LAUNCHES 1
#endif

#define LAS __attribute__((address_space(3)))
typedef unsigned short bf16_t;
typedef short bf16x8 __attribute__((ext_vector_type(8)));
typedef short s16x4 __attribute__((ext_vector_type(4)));
typedef float f32x2 __attribute__((ext_vector_type(2)));
typedef float f32x4 __attribute__((ext_vector_type(4)));
typedef float f32x16 __attribute__((ext_vector_type(16)));
typedef unsigned u32x2 __attribute__((ext_vector_type(2)));
typedef unsigned u32x4 __attribute__((ext_vector_type(4)));
typedef __bf16 bfv2 __attribute__((ext_vector_type(2)));

constexpr int M = 8192, D = 2048, INW = 8704, FF = 5632, FF2 = 11264;
constexpr int QA_OFF = 0, KA_OFF = 1024, VA_OFF = 1280, QB_OFF = 1536, KB_OFF = 2560, VB_OFF = 3584, GA_OFF = 4608, GB_OFF = 6656;
constexpr float EPS = 1e-6f, LOG2E = 1.4426950408889634f, QSCALE = 0.125f * LOG2E;
constexpr int NPH = 8;
constexpr size_t MiB = 1u << 20;
constexpr size_t WS_WIN = 0, WS_WAB = 34 * MiB, WS_WOUT = 42 * MiB, WS_WFFN = 50 * MiB, WS_WDN = 94 * MiB;
constexpr size_t WS_XN = 116 * MiB;
constexpr size_t WS_ATT = 148 * MiB;
constexpr size_t WS_PROJ = 180 * MiB;
constexpr size_t WS_RSQ = 316 * MiB, WS_CTL = 317 * MiB, CTL_BYTES = 20480, WS_END = 318 * MiB;
constexpr int LDS_BYTES = 131072 + 1024;

__device__ __forceinline__ unsigned pk2(float lo, float hi) { f32x2 v = {lo, hi}; return __builtin_bit_cast(unsigned, __builtin_convertvector(v, bfv2)); }
__device__ __forceinline__ float bflo(unsigned w) { return __builtin_bit_cast(float, w << 16); }
__device__ __forceinline__ float bfhi(unsigned w) { return __builtin_bit_cast(float, w & 0xffff0000u); }
__device__ __forceinline__ float fsigmoid(float g) { return __builtin_amdgcn_rcpf(1.f + __builtin_amdgcn_exp2f(-g * LOG2E)); }

namespace pg8 {
constexpr int BM = 256, BK = 64, HALF = 128, HTB = HALF * BK * 2, STAGE_BYTES = 8 * HTB, NXCD = 8, WGM = 8;
__device__ __forceinline__ int lds_byte(int r, int c) { const int st = (r >> 4) * 2 + (c >> 5), rr = r & 15, cc = c & 31, ob = rr * 64 + cc * 2; return st * 1024 + (ob ^ (((ob >> 9) & 1) << 5)); }
__device__ __forceinline__ void stage_rc(int b, int& R, int& C) { const int st = b / 1024, sb = b % 1024, swz = sb ^ (((sb >> 9) & 1) << 5); R = (st >> 1) * 16 + swz / 64; C = (st & 1) * 32 + (swz % 64) / 2; }
__device__ __forceinline__ int perm32(int rho) { const int n = rho >> 4, i = rho & 15; return 8 * (i >> 2) + 4 * n + (i & 3); }

struct Unit { int pm, pn, z; };
struct Gemm { const bf16_t* A; const bf16_t* Bt; int lda, ldb, K; size_t zoffA, zoffB; };

struct StaticOrder {
    int nM, nN, nwg, G, c, nz;
    __device__ void init(int M_, int N_, int G_, int c_, int nz_) { nM = M_ / BM; nN = N_ / BM; nwg = nM * nN; G = G_; c = c_; nz = nz_; }
    __device__ bool next(int i, Unit& u) const {
        const int ti = i / nz; u.z = i - ti * nz;
        const long L = (long)ti * G + c; if (L >= nwg) return false;
        int wgid = (int)L; { const int q = nwg / NXCD, r = nwg % NXCD, xcd = wgid % NXCD, off = wgid / NXCD; wgid = (xcd < r ? xcd * (q + 1) : r * (q + 1) + (xcd - r) * q) + off; }
        const int nig = WGM * nN, gid = wgid / nig, fm = gid * WGM, gsz = (nM - fm) < WGM ? (nM - fm) : WGM;
        u.pm = fm + ((wgid % nig) % gsz); u.pn = (wgid % nig) / gsz; return true;
    }
};

#define EPI_ROW(u, ai, m) ((u).pm * 256 + (ai) * 128 + wr * 64 + (m) * 16 + fr)
#define EPI_COL(u, bj) ((u).pn * 256 + (bj) * 128 + wc * 32 + 8 * fq)

__device__ __forceinline__ void ld_row8(const float* p  , int fq, f32x4& v0, f32x4& v1) {
    const bool odd = fq & 1;
    const f32x4 a = *(const f32x4*)(p + (odd ? -4 : 0)), b = *(const f32x4*)(p + (odd ? 4 : 8));
    f32x4 send = odd ? a : b, recv;
#pragma unroll
    for (int c = 0; c < 4; ++c) recv[c] = __shfl_xor(send[c], 16);
    v0 = odd ? recv : a; v1 = odd ? b : recv;
}
struct EpiStoreBf16 {
    static constexpr bool AFTER_DRAIN = false;
    bf16_t* O; int ldc;
    __device__ __forceinline__ void operator()(const f32x4 (&acc)[2][2][4][2], const Unit& u, int wr, int wc, int fr, int fq) const {
#pragma unroll
        for (int ai = 0; ai < 2; ++ai)
#pragma unroll
            for (int m = 0; m < 4; ++m) { bf16_t* rowp = O + (size_t)EPI_ROW(u, ai, m) * ldc;
#pragma unroll
                for (int bj = 0; bj < 2; ++bj) { const f32x4 v0 = acc[ai][bj][m][0], v1 = acc[ai][bj][m][1];
                    u32x4 w; w.x = pk2(v0[0], v0[1]); w.y = pk2(v0[2], v0[3]); w.z = pk2(v1[0], v1[1]); w.w = pk2(v1[2], v1[3]);
                    *(u32x4*)(rowp + EPI_COL(u, bj)) = w; } }
    }
};
struct EpiProj {
    static constexpr bool AFTER_DRAIN = false;
    bf16_t* QKV; bf16_t* Gb;
    __device__ __forceinline__ void operator()(const f32x4 (&acc)[2][2][4][2], const Unit& u, int wr, int wc, int fr, int fq) const {
        const bool isg = u.pn >= 18;
#pragma unroll
        for (int ai = 0; ai < 2; ++ai)
#pragma unroll
            for (int m = 0; m < 4; ++m) { const int r = EPI_ROW(u, ai, m);
#pragma unroll
                for (int bj = 0; bj < 2; ++bj) { const int c = EPI_COL(u, bj); const f32x4 v0 = acc[ai][bj][m][0], v1 = acc[ai][bj][m][1];
                    u32x4 w; w.x = pk2(v0[0], v0[1]); w.y = pk2(v0[2], v0[3]); w.z = pk2(v1[0], v1[1]); w.w = pk2(v1[2], v1[3]);
                    bf16_t* dst = isg ? Gb + (size_t)r * 4096 + (c - GA_OFF) : QKV + ((size_t)(c >> 6) * M + r) * 64 + (c & 63);
                    *(u32x4*)dst = w; } }
    }
};
struct EpiBranch {
    static constexpr bool AFTER_DRAIN = false;
    const bf16_t* Gb; float* T; bf16_t* MRG;
    __device__ __forceinline__ void operator()(const f32x4 (&acc)[2][2][4][2], const Unit& u, int wr, int wc, int fr, int fq) const {
        const int goff = (u.z == 0) ? 0 : 2048;
#pragma unroll
        for (int ai = 0; ai < 2; ++ai) {
            u32x4 gw[4][2], tw[4][2];
#pragma unroll
            for (int m = 0; m < 4; ++m)
#pragma unroll
                for (int bj = 0; bj < 2; ++bj) gw[m][bj] = *(const u32x4*)(Gb + (size_t)EPI_ROW(u, ai, m) * 4096 + goff + EPI_COL(u, bj));
            if (u.z != 0) {
#pragma unroll
                for (int m = 0; m < 4; ++m)
#pragma unroll
                    for (int bj = 0; bj < 2; ++bj) tw[m][bj] = *(const u32x4*)((const bf16_t*)T + (size_t)EPI_ROW(u, ai, m) * D + EPI_COL(u, bj));
            }
#pragma unroll
            for (int m = 0; m < 4; ++m) { const int r = EPI_ROW(u, ai, m);
#pragma unroll
                for (int bj = 0; bj < 2; ++bj) { const int c = EPI_COL(u, bj); const u32x4 g = gw[m][bj];
                    f32x4 v0 = acc[ai][bj][m][0], v1 = acc[ai][bj][m][1];
                    v0[0] *= fsigmoid(bflo(g.x)); v0[1] *= fsigmoid(bfhi(g.x)); v0[2] *= fsigmoid(bflo(g.y)); v0[3] *= fsigmoid(bfhi(g.y));
                    v1[0] *= fsigmoid(bflo(g.z)); v1[1] *= fsigmoid(bfhi(g.z)); v1[2] *= fsigmoid(bflo(g.w)); v1[3] *= fsigmoid(bfhi(g.w));
                    if (u.z != 0) { const u32x4 t = tw[m][bj];
                        v0[0] += bflo(t.x); v0[1] += bfhi(t.x); v0[2] += bflo(t.y); v0[3] += bfhi(t.y); v1[0] += bflo(t.z); v1[1] += bfhi(t.z); v1[2] += bflo(t.w); v1[3] += bfhi(t.w); }
                    u32x4 w; w.x = pk2(v0[0], v0[1]); w.y = pk2(v0[2], v0[3]); w.z = pk2(v1[0], v1[1]); w.w = pk2(v1[2], v1[3]);
                    if (u.z == 0) *(u32x4*)((bf16_t*)T + (size_t)r * D + c) = w;
                    else *(u32x4*)(MRG + (size_t)r * D + c) = w; } }
        }
    }
};
struct EpiRes1 {
    static constexpr bool AFTER_DRAIN = false;
    const float* x; float* x1; bf16_t* x1b; float* rsq; bool write_f32;
    __device__ __forceinline__ void operator()(const f32x4 (&acc)[2][2][4][2], const Unit& u, int wr, int wc, int fr, int fq) const {
#pragma unroll
        for (int ai = 0; ai < 2; ++ai)
#pragma unroll
            for (int m = 0; m < 4; ++m) { const int r = EPI_ROW(u, ai, m); float ss = 0.f;
#pragma unroll
                for (int bj = 0; bj < 2; ++bj) { const int c = EPI_COL(u, bj); const size_t off = (size_t)r * D + c;
                    const f32x4 v0 = acc[ai][bj][m][0] + *(const f32x4*)(x + off), v1 = acc[ai][bj][m][1] + *(const f32x4*)(x + off + 4);
                    if (write_f32) { *(f32x4*)(x1 + off) = v0; *(f32x4*)(x1 + off + 4) = v1; }
                    ss += (v0[0] * v0[0] + v0[1] * v0[1]) + (v0[2] * v0[2] + v0[3] * v0[3]) + (v1[0] * v1[0] + v1[1] * v1[1]) + (v1[2] * v1[2] + v1[3] * v1[3]);
                    u32x4 w; w.x = pk2(v0[0], v0[1]); w.y = pk2(v0[2], v0[3]); w.z = pk2(v1[0], v1[1]); w.w = pk2(v1[2], v1[3]);
                    *(u32x4*)(x1b + off) = w; }
                ss += __shfl_xor(ss, 16); ss += __shfl_xor(ss, 32);
                if (fq == 0) rsq[(size_t)r * 32 + u.pn * 4 + wc] = ss; }
    }
};
struct EpiSwiglu {
    static constexpr bool AFTER_DRAIN = false;
    const float* rsq; bf16_t* H;
    __device__ __forceinline__ void operator()(const f32x4 (&acc)[2][2][4][2], const Unit& u, int wr, int wc, int fr, int fq) const {
#pragma unroll
        for (int ai = 0; ai < 2; ++ai)
#pragma unroll
            for (int m = 0; m < 4; ++m) { const int r = EPI_ROW(u, ai, m);
                const f32x4 p0 = *(const f32x4*)(rsq + (size_t)r * 32 + 8 * fq), p1 = *(const f32x4*)(rsq + (size_t)r * 32 + 8 * fq + 4);
                float s = ((p0[0] + p0[1]) + (p0[2] + p0[3])) + ((p1[0] + p1[1]) + (p1[2] + p1[3]));
                s += __shfl_xor(s, 16); s += __shfl_xor(s, 32);
                const float inv = rsqrtf(s * (1.0f / D) + EPS);
                float h[8];
#pragma unroll
                for (int n = 0; n < 2; ++n)
#pragma unroll
                    for (int j = 0; j < 4; ++j) { const float g = acc[ai][0][m][n][j] * inv, up = acc[ai][1][m][n][j] * inv; h[4 * n + j] = g * fsigmoid(g) * up; }
                u32x4 w; w.x = pk2(h[0], h[1]); w.y = pk2(h[2], h[3]); w.z = pk2(h[4], h[5]); w.w = pk2(h[6], h[7]);
                *(u32x4*)(H + (size_t)r * FF + u.pn * 128 + wc * 32 + 8 * fq) = w; }
    }
};
struct EpiRes2 {
    static constexpr bool AFTER_DRAIN = false;
    float* x;
    __device__ __forceinline__ void operator()(const f32x4 (&acc)[2][2][4][2], const Unit& u, int wr, int wc, int fr, int fq) const {
#pragma unroll
        for (int ai = 0; ai < 2; ++ai)
#pragma unroll
            for (int m = 0; m < 4; ++m) { const int r = EPI_ROW(u, ai, m);
#pragma unroll
                for (int bj = 0; bj < 2; ++bj) { float* p = x + (size_t)r * D + EPI_COL(u, bj);
                    const f32x4 v0 = acc[ai][bj][m][0] + *(const f32x4*)p, v1 = acc[ai][bj][m][1] + *(const f32x4*)(p + 4);
                    *(f32x4*)p = v0; *(f32x4*)(p + 4) = v1; } }
    }
};

__device__ __forceinline__ void panel_exchange(LAS unsigned char* lds, const Unit& u, int wid, int lane, float* xb, unsigned* cnt, unsigned* tmo) {
    LAS float* P = (LAS float*)lds; LAS float* T = (LAS float*)(lds + 4096);
    asm volatile("s_waitcnt lgkmcnt(0)" ::: "memory"); __builtin_amdgcn_s_barrier(); asm volatile("" ::: "memory");
    const int tid = wid * 64 + lane;
    if (tid < 256) {
        const float part = (P[tid * 4 + 0] + P[tid * 4 + 1]) + (P[tid * 4 + 2] + P[tid * 4 + 3]);
        __hip_atomic_store(xb + ((size_t)(u.pm * 256 + tid) * 8 + u.pn), part, __ATOMIC_RELAXED, __HIP_MEMORY_SCOPE_AGENT);
        asm volatile("s_waitcnt vmcnt(0)" ::: "memory");
        if (lane == 0) __hip_atomic_fetch_add(cnt + 16 * u.pm, 1u, __ATOMIC_RELAXED, __HIP_MEMORY_SCOPE_AGENT);
    }
    if (wid == 0) {
        unsigned sp = 0;
        while ((unsigned)__builtin_amdgcn_readfirstlane(__hip_atomic_load(cnt + 16 * u.pm, __ATOMIC_RELAXED, __HIP_MEMORY_SCOPE_AGENT)) < 32u) {
            __builtin_amdgcn_s_sleep(1);
            if ((++sp & 255u) == 0u) { if (__hip_atomic_load(tmo, __ATOMIC_RELAXED, __HIP_MEMORY_SCOPE_AGENT)) break; if (sp > (1u << 18)) { atomicAdd(tmo, 1u); break; } }
        }
        __builtin_amdgcn_fence(__ATOMIC_ACQUIRE, "agent");
    }
    asm volatile("s_waitcnt vmcnt(0) lgkmcnt(0)" ::: "memory"); __builtin_amdgcn_s_barrier(); asm volatile("" ::: "memory");
    if (tid < 256) {
        const float* slot = xb + (size_t)(u.pm * 256 + tid) * 8; float t = 0.f;
#pragma unroll
        for (int k = 0; k < 8; ++k) t += __hip_atomic_load(slot + k, __ATOMIC_RELAXED, __HIP_MEMORY_SCOPE_AGENT);
        T[tid] = t * (1.0f / D) + EPS;
    }
    asm volatile("s_waitcnt lgkmcnt(0)" ::: "memory"); __builtin_amdgcn_s_barrier(); asm volatile("" ::: "memory");
}
#define EPI_SS8(v0, v1) (((v0)[0] * (v0)[0] + (v0)[1] * (v0)[1]) + ((v0)[2] * (v0)[2] + (v0)[3] * (v0)[3]) + ((v1)[0] * (v1)[0] + (v1)[1] * (v1)[1]) + ((v1)[2] * (v1)[2] + (v1)[3] * (v1)[3]))
struct EpiRes1F {
    static constexpr bool AFTER_DRAIN = true;
    const float* x; bf16_t* x1n; float* rms; float* xb; unsigned* cnt; unsigned* tmo;
    __device__ __forceinline__ void fused(f32x4 (&acc)[2][2][4][2], const Unit& u, int wr, int wc, int fr, int fq, LAS unsigned char* lds, int wid, int lane) const {
        LAS float* P = (LAS float*)lds; const LAS float* T = (const LAS float*)(lds + 4096);
#pragma unroll
        for (int ai = 0; ai < 2; ++ai) {
            f32x4 xv[4][2][2];
#pragma unroll
            for (int m = 0; m < 4; ++m)
#pragma unroll
                for (int bj = 0; bj < 2; ++bj) ld_row8(x + (size_t)EPI_ROW(u, ai, m) * D + EPI_COL(u, bj), fq, xv[m][bj][0], xv[m][bj][1]);
#pragma unroll
            for (int m = 0; m < 4; ++m) { float ss = 0.f;
#pragma unroll
                for (int bj = 0; bj < 2; ++bj) { const f32x4 v0 = acc[ai][bj][m][0] + xv[m][bj][0], v1 = acc[ai][bj][m][1] + xv[m][bj][1];
                    acc[ai][bj][m][0] = v0; acc[ai][bj][m][1] = v1; ss += EPI_SS8(v0, v1); }
                ss += __shfl_xor(ss, 16); ss += __shfl_xor(ss, 32);
                if (fq == 0) P[(ai * 128 + wr * 64 + m * 16 + fr) * 4 + wc] = ss; }
        }
        panel_exchange(lds, u, wid, lane, xb, cnt, tmo);
        const int tid = wid * 64 + lane;
        if (u.pn == 0 && tid < 256) { const float t = T[tid]; rms[u.pm * 256 + tid] = t * rsqrtf(t); }
#pragma unroll
        for (int ai = 0; ai < 2; ++ai)
#pragma unroll
            for (int m = 0; m < 4; ++m) { const int rl = ai * 128 + wr * 64 + m * 16 + fr; const float inv = rsqrtf(T[rl]); const int r = u.pm * 256 + rl;
#pragma unroll
                for (int bj = 0; bj < 2; ++bj) { const f32x4 v0 = acc[ai][bj][m][0] * inv, v1 = acc[ai][bj][m][1] * inv;
                    u32x4 w; w.x = pk2(v0[0], v0[1]); w.y = pk2(v0[2], v0[3]); w.z = pk2(v1[0], v1[1]); w.w = pk2(v1[2], v1[3]);
                    *(u32x4*)(x1n + (size_t)r * D + EPI_COL(u, bj)) = w; } }
    }
};
struct EpiSwigluN {
    static constexpr bool AFTER_DRAIN = false;
    bf16_t* H;
    __device__ __forceinline__ void operator()(const f32x4 (&acc)[2][2][4][2], const Unit& u, int wr, int wc, int fr, int fq) const {
#pragma unroll
        for (int ai = 0; ai < 2; ++ai)
#pragma unroll
            for (int m = 0; m < 4; ++m) { const int r = EPI_ROW(u, ai, m);
                float h[8];
#pragma unroll
                for (int n = 0; n < 2; ++n)
#pragma unroll
                    for (int j = 0; j < 4; ++j) { const float g = acc[ai][0][m][n][j]; h[4 * n + j] = g * fsigmoid(g) * acc[ai][1][m][n][j]; }
                u32x4 w; w.x = pk2(h[0], h[1]); w.y = pk2(h[2], h[3]); w.z = pk2(h[4], h[5]); w.w = pk2(h[6], h[7]);
                *(u32x4*)(H + (size_t)r * FF + u.pn * 128 + wc * 32 + 8 * fq) = w; }
    }
};
struct EpiFinal {
    static constexpr bool AFTER_DRAIN = true;
    const bf16_t* x1n; const float* rms; float* out; const float* gfin; float* xb; unsigned* cnt; unsigned* tmo;
    __device__ __forceinline__ void fused(f32x4 (&acc)[2][2][4][2], const Unit& u, int wr, int wc, int fr, int fq, LAS unsigned char* lds, int wid, int lane) const {
        LAS float* P = (LAS float*)lds; const LAS float* T = (const LAS float*)(lds + 4096);
        u32x4 xw[2][4][2]; float rmv[2][4];
#pragma unroll
        for (int ai = 0; ai < 2; ++ai)
#pragma unroll
            for (int m = 0; m < 4; ++m) { const int r = EPI_ROW(u, ai, m); rmv[ai][m] = rms[r];
#pragma unroll
                for (int bj = 0; bj < 2; ++bj) xw[ai][m][bj] = *(const u32x4*)(x1n + (size_t)r * D + EPI_COL(u, bj)); }
#pragma unroll
        for (int ai = 0; ai < 2; ++ai)
#pragma unroll
            for (int m = 0; m < 4; ++m) { float ss = 0.f; const float rm = rmv[ai][m];
#pragma unroll
                for (int bj = 0; bj < 2; ++bj) { const u32x4 w = xw[ai][m][bj];
                    const f32x4 v0 = acc[ai][bj][m][0] + (f32x4){bflo(w.x), bfhi(w.x), bflo(w.y), bfhi(w.y)} * rm, v1 = acc[ai][bj][m][1] + (f32x4){bflo(w.z), bfhi(w.z), bflo(w.w), bfhi(w.w)} * rm;
                    acc[ai][bj][m][0] = v0; acc[ai][bj][m][1] = v1; ss += EPI_SS8(v0, v1); }
                ss += __shfl_xor(ss, 16); ss += __shfl_xor(ss, 32);
                if (fq == 0) P[(ai * 128 + wr * 64 + m * 16 + fr) * 4 + wc] = ss; }
        f32x4 gg[2][2];
#pragma unroll
        for (int bj = 0; bj < 2; ++bj) { const int c = EPI_COL(u, bj); gg[bj][0] = *(const f32x4*)(gfin + c); gg[bj][1] = *(const f32x4*)(gfin + c + 4); }
        panel_exchange(lds, u, wid, lane, xb, cnt, tmo);
#pragma unroll
        for (int ai = 0; ai < 2; ++ai)
#pragma unroll
            for (int m = 0; m < 4; ++m) { const int rl = ai * 128 + wr * 64 + m * 16 + fr; const float inv = rsqrtf(T[rl]); const int r = u.pm * 256 + rl;
#pragma unroll
                for (int bj = 0; bj < 2; ++bj) { const int c = EPI_COL(u, bj); const f32x4 g0 = gg[bj][0], g1 = gg[bj][1];
                    float* p = out + (size_t)r * D + c;
                    *(f32x4*)p = acc[ai][bj][m][0] * inv * g0; *(f32x4*)(p + 4) = acc[ai][bj][m][1] * inv * g1; } }
    }
};

template <class Epi, bool ALIGN_EPI>
__device__ __forceinline__ void gemm_phase(LAS unsigned char* lds, const Gemm g, const StaticOrder& S, Epi E) {
    const int tid = threadIdx.x, wid = __builtin_amdgcn_readfirstlane(tid >> 6), lane = tid & 63, wr = wid >> 2, wc = wid & 3, fr = lane & 15, fq = lane >> 4;
    const int nt = g.K / BK;
    unsigned voffA[2], voffB[2];
#pragma unroll
    for (int i = 0; i < 2; ++i) { int R, C; stage_rc(tid * 16 + i * 8192, R, C); const int Rb = (R & ~31) + perm32(R & 31);
        voffA[i] = (unsigned)(R * g.lda + C) * 2u; voffB[i] = (unsigned)(Rb * g.ldb + C) * 2u; }
    const size_t kstep = (size_t)(BK * 2);
    const size_t hA = (size_t)HALF * g.lda * 2, hB = (size_t)HALF * g.ldb * 2;
    const size_t tA = 2 * hA, tB = 2 * hB;
    const unsigned ldsw = (unsigned)wid * 1024u;
    const int aoff = lds_byte(wr * 64 + fr, fq * 8), boff = lds_byte(wc * 32 + fr, fq * 8);
#define PG8_SA(b, h) (((b) * 2 + (h)) * HTB)
#define PG8_SB(b, h) ((4 + (b) * 2 + (h)) * HTB)
#define PG8_STAGE(bufoff, gbase, voff) do { _Pragma("unroll") for (int _i = 0; _i < 2; ++_i) \
        __builtin_amdgcn_global_load_lds((const unsigned*)((const char*)(gbase) + (voff)[_i]), (LAS unsigned*)(lds + (bufoff) + ldsw + _i * 8192), 16, 0, 0); } while (0)
#define PG8_LDA(dst, b, h) do { _Pragma("unroll") for (int m = 0; m < 4; ++m) _Pragma("unroll") for (int k = 0; k < 2; ++k) dst[m][k] = *(const LAS bf16x8*)(lds + PG8_SA(b, h) + aoff + m * 2048 + k * 1024); } while (0)
#define PG8_LDB(dst, b, h) do { _Pragma("unroll") for (int n = 0; n < 2; ++n) _Pragma("unroll") for (int k = 0; k < 2; ++k) dst[n][k] = *(const LAS bf16x8*)(lds + PG8_SB(b, h) + boff + n * 2048 + k * 1024); } while (0)
#define PG8_MMA(ai, bj, At, Bt) do { __builtin_amdgcn_s_setprio(1); _Pragma("unroll") for (int m = 0; m < 4; ++m) _Pragma("unroll") for (int n = 0; n < 2; ++n) _Pragma("unroll") for (int k = 0; k < 2; ++k) \
        acc[ai][bj][m][n] = __builtin_amdgcn_mfma_f32_16x16x32_bf16(Bt[n][k], At[m][k], acc[ai][bj][m][n], 0, 0, 0); __builtin_amdgcn_s_setprio(0); } while (0)
#define PG8_WAIT_V(n) asm volatile("s_waitcnt vmcnt(" #n ")" ::: "memory")
#define PG8_WAIT_L(n) asm volatile("s_waitcnt lgkmcnt(" #n ")" ::: "memory")
#define PG8_BAR __builtin_amdgcn_s_barrier()
#define PG8_SCHED __builtin_amdgcn_sched_barrier(0)
    Unit cur, nxt; int ui = 0;
    if (!S.next(0, cur)) return;
    f32x4 acc[2][2][4][2];
#pragma unroll
    for (int a = 0; a < 2; ++a)
#pragma unroll
        for (int b = 0; b < 2; ++b)
#pragma unroll
            for (int m = 0; m < 4; ++m)
#pragma unroll
                for (int n = 0; n < 2; ++n) acc[a][b][m][n] = (f32x4){0.f, 0.f, 0.f, 0.f};
    bf16x8 At[4][2], B0[2][2], B1[2][2];
    const char* cA = (const char*)g.A + (size_t)cur.pm * tA + (size_t)cur.z * g.zoffA; const char* cB = (const char*)g.Bt + (size_t)cur.pn * tB + (size_t)cur.z * g.zoffB;
    PG8_STAGE(PG8_SB(0, 0), cB, voffB); PG8_STAGE(PG8_SB(0, 1), cB + hB, voffB); PG8_STAGE(PG8_SA(0, 0), cA, voffA); PG8_STAGE(PG8_SA(0, 1), cA + hA, voffA);
    if (wr == 1) PG8_BAR;
    PG8_WAIT_V(2); PG8_BAR;
    PG8_STAGE(PG8_SB(1, 0), cB + kstep, voffB); PG8_STAGE(PG8_SA(1, 0), cA + kstep, voffA); PG8_STAGE(PG8_SB(1, 1), cB + hB + kstep, voffB);
    PG8_WAIT_V(6); PG8_BAR;
    for (;;) {
        const bool has_next = S.next(ui + 1, nxt);
        const char* nA = has_next ? (const char*)g.A + (size_t)nxt.pm * tA + (size_t)nxt.z * g.zoffA : cA; const char* nB = has_next ? (const char*)g.Bt + (size_t)nxt.pn * tB + (size_t)nxt.z * g.zoffB : cB;
        for (int t = 0; t < nt; t += 2) {
            const bool last = (t == nt - 2);
            const char* a1 = cA + (size_t)(t + 1) * kstep;
            const char* a2 = last ? nA : cA + (size_t)(t + 2) * kstep; const char* b2 = last ? nB : cB + (size_t)(t + 2) * kstep;
            const char* a3 = a2 + kstep; const char* b3 = b2 + kstep;
            PG8_LDB(B0, 0, 0); PG8_LDB(B1, 0, 1); PG8_SCHED; PG8_LDA(At, 0, 0); PG8_STAGE(PG8_SA(1, 1), a1 + hA, voffA);
            PG8_WAIT_V(8); PG8_WAIT_L(0); PG8_BAR; PG8_MMA(0, 0, At, B0); PG8_MMA(0, 1, At, B1); PG8_BAR; PG8_SCHED;
            PG8_LDA(At, 0, 1); PG8_STAGE(PG8_SB(0, 0), b2, voffB); PG8_STAGE(PG8_SB(0, 1), b2 + hB, voffB); PG8_STAGE(PG8_SA(0, 0), a2, voffA);
            PG8_WAIT_V(8); PG8_WAIT_L(0); PG8_BAR; PG8_MMA(1, 0, At, B0); PG8_MMA(1, 1, At, B1); PG8_BAR; PG8_SCHED;
            PG8_LDB(B0, 1, 0); PG8_LDB(B1, 1, 1); PG8_SCHED; PG8_LDA(At, 1, 0); PG8_STAGE(PG8_SA(0, 1), a2 + hA, voffA);
            PG8_WAIT_V(8); PG8_WAIT_L(0); PG8_BAR; PG8_MMA(0, 0, At, B0); PG8_MMA(0, 1, At, B1); PG8_BAR; PG8_SCHED;
            PG8_LDA(At, 1, 1); PG8_STAGE(PG8_SB(1, 0), b3, voffB); PG8_STAGE(PG8_SB(1, 1), b3 + hB, voffB); PG8_STAGE(PG8_SA(1, 0), a3, voffA);
            PG8_WAIT_V(8); PG8_WAIT_L(0); PG8_BAR; PG8_MMA(1, 0, At, B0); PG8_MMA(1, 1, At, B1); PG8_BAR; PG8_SCHED;
        }
        if constexpr (ALIGN_EPI) { if (wr == 0) PG8_BAR; }
        if constexpr (!Epi::AFTER_DRAIN) E(acc, cur, wr, wc, fr, fq);
        if (!has_next) break;
#pragma unroll
        for (int a = 0; a < 2; ++a)
#pragma unroll
            for (int b = 0; b < 2; ++b)
#pragma unroll
                for (int m = 0; m < 4; ++m)
#pragma unroll
                    for (int n = 0; n < 2; ++n) acc[a][b][m][n] = (f32x4){0.f, 0.f, 0.f, 0.f};
        cur = nxt; cA = nA; cB = nB; ++ui;
        if constexpr (ALIGN_EPI) { if (wr == 1) PG8_BAR; }
    }
    PG8_WAIT_V(0);
    if constexpr (!ALIGN_EPI) { if (wr == 0) PG8_BAR; }
    PG8_BAR;
    if constexpr (Epi::AFTER_DRAIN) E.fused(acc, cur, wr, wc, fr, fq, lds, wid, lane);
#undef PG8_SA
#undef PG8_SB
#undef PG8_STAGE
#undef PG8_LDA
#undef PG8_LDB
#undef PG8_MMA
#undef PG8_WAIT_V
#undef PG8_WAIT_L
#undef PG8_BAR
#undef PG8_SCHED
}
}

#define MFMA32(a, b, c) __builtin_amdgcn_mfma_f32_32x32x16_bf16((a), (b), (c), 0, 0, 0)
constexpr float SB_EXIT = -150.0f;
constexpr int WIN_KEYS = 448;
constexpr int KW_PITCH = 144;
constexpr int VW_PITCH = WIN_KEYS * 2 + 8;
constexpr int VW_OFF = WIN_KEYS * KW_PITCH;
constexpr int ATT_FLAG_OFF = VW_OFF + 64 * VW_PITCH;
static_assert(ATT_FLAG_OFF + 16 <= 131072 && VW_OFF % 16 == 0, "attention LDS map");

struct WinRegs { bf16x8 kv[7]; bf16x8 vv[8]; };
__device__ __forceinline__ void win_issue(WinRegs& w, const bf16_t* Kp, const bf16_t* Vp, int W0, int nk, int tid) {
    const bf16x8* ksrc = (const bf16x8*)(Kp + (size_t)W0 * 64);
#pragma unroll
    for (int i = 0; i < 7; ++i) { const int idx = tid + 512 * i; w.kv[i] = ksrc[idx < nk * 8 ? idx : 0]; }
    const bf16_t* vp = Vp + (size_t)(W0 + (tid < nk ? tid : 0)) * 64;
#pragma unroll
    for (int c = 0; c < 8; ++c) w.vv[c] = *(const bf16x8*)(vp + 8 * c);
}
__device__ __forceinline__ void win_commit(LAS unsigned char* lds, const WinRegs& w, int nk, int tid) {
#pragma unroll
    for (int i = 0; i < 7; ++i) { const int idx = tid + 512 * i; if (idx < nk * 8) *(LAS bf16x8*)(lds + (idx >> 3) * KW_PITCH + 16 * (idx & 7)) = w.kv[i]; }
    if (tid < nk) {
#pragma unroll
        for (int c = 0; c < 8; ++c)
#pragma unroll
            for (int j = 0; j < 8; ++j) *(LAS bf16_t*)(lds + VW_OFF + (8 * c + j) * VW_PITCH + 2 * tid) = (bf16_t)w.vv[c][j];
    }
}
__device__ __forceinline__ f32x16 qk_tile(const LAS unsigned char* lds, int kr0, const bf16x8 (&Bq)[4], int q, int hi) {
    f32x16 S;
#pragma unroll
    for (int i = 0; i < 16; ++i) S[i] = 0.f;
    const LAS unsigned char* kp = lds + (kr0 + q) * KW_PITCH + 16 * hi;
#pragma unroll
    for (int kk = 0; kk < 4; ++kk) S = MFMA32(*(const LAS bf16x8*)(kp + 32 * kk), Bq[kk], S);
    return S;
}
__device__ __forceinline__ void pv_acc(const LAS unsigned char* lds, int kr0, const bf16x8 (&P)[2], f32x16& O0, f32x16& O1, int q, int hi) {
#pragma unroll
    for (int c = 0; c < 2; ++c) {
        const LAS unsigned char* p0 = lds + VW_OFF + q * VW_PITCH + (kr0 + 16 * c + 4 * hi) * 2;
        const LAS unsigned char* p1 = p0 + 32 * VW_PITCH;
        const s16x4 a0 = *(const LAS s16x4*)p0, a1 = *(const LAS s16x4*)(p0 + 16);
        const s16x4 b0 = *(const LAS s16x4*)p1, b1 = *(const LAS s16x4*)(p1 + 16);
        const bf16x8 A0 = {a0[0], a0[1], a0[2], a0[3], a1[0], a1[1], a1[2], a1[3]};
        const bf16x8 A1 = {b0[0], b0[1], b0[2], b0[3], b1[0], b1[1], b1[2], b1[3]};
        O0 = MFMA32(A0, P[c], O0); O1 = MFMA32(A1, P[c], O1);
    }
}
__device__ __forceinline__ void pack_p(const float (&a)[16], bf16x8 (&P)[2]) {
#pragma unroll
    for (int c = 0; c < 2; ++c) { u32x4 w; w.x = pk2(a[8 * c], a[8 * c + 1]); w.y = pk2(a[8 * c + 2], a[8 * c + 3]); w.z = pk2(a[8 * c + 4], a[8 * c + 5]); w.w = pk2(a[8 * c + 6], a[8 * c + 7]);
        P[c] = __builtin_bit_cast(bf16x8, w); }
}
typedef unsigned u32x2s __attribute__((ext_vector_type(2)));
__device__ __forceinline__ void store_o_half(bf16_t* p  , const f32x16& O, float sc, int hi) {
#pragma unroll
    for (int pr = 0; pr < 2; ++pr) { const int ge = 2 * pr, go = 2 * pr + 1;
        const unsigned ex = pk2(O[4 * ge] * sc, O[4 * ge + 1] * sc), ey = pk2(O[4 * ge + 2] * sc, O[4 * ge + 3] * sc);
        const unsigned ox = pk2(O[4 * go] * sc, O[4 * go + 1] * sc), oy = pk2(O[4 * go + 2] * sc, O[4 * go + 3] * sc);
        const u32x2s sx = __builtin_amdgcn_permlane32_swap(ex, ox, false, false), sy = __builtin_amdgcn_permlane32_swap(ey, oy, false, false);
        u32x4 v; v.x = sx.x; v.y = sy.x; v.z = sx.y; v.w = sy.y;
        *(u32x4*)(p + 8 * (2 * pr + hi)) = v; }
}
__device__ __forceinline__ void store_o(bf16_t* orow  , const f32x16& O0, const f32x16& O1, float sc, int hi) {
    store_o_half(orow, O0, sc, hi); store_o_half(orow + 32, O1, sc, hi);
}

template <bool DIAG>
__device__ __forceinline__ void sb_tile(const f32x16& S, int q, int hi, float& carry, float& cl, bf16x8 (&P)[2]) {
    float bt[16], fl[16], a[16];
#pragma unroll
    for (int i = 0; i < 16; ++i) {
        const float y = S[i];
        const float e = __builtin_amdgcn_exp2f(-fabsf(y)), r = __builtin_amdgcn_rcpf(1.f + e), er = e * r;
        const bool pos = y >= 0.f;
        bt[i] = pos ? r : er; fl[i] = pos ? er : r;
        if (DIAG) { const int key = 8 * (i >> 2) + 4 * hi + (i & 3); if (!(key < q)) { bt[i] = 0.f; fl[i] = 1.f; } }
    }
    float g[4], pg[4];
#pragma unroll
    for (int gi = 0; gi < 4; ++gi) { g[gi] = (fl[4 * gi] * fl[4 * gi + 1]) * (fl[4 * gi + 2] * fl[4 * gi + 3]); pg[gi] = __shfl_xor(g[gi], 32); }
    float above = cl, tp = 1.f;
#pragma unroll
    for (int gi = 3; gi >= 0; --gi) {
        const float s3 = above * (hi == 0 ? pg[gi] : 1.f);
        const float s2 = s3 * fl[4 * gi + 3], s1 = s2 * fl[4 * gi + 2], s0 = s1 * fl[4 * gi + 1];
        a[4 * gi + 3] = bt[4 * gi + 3] * s3; a[4 * gi + 2] = bt[4 * gi + 2] * s2; a[4 * gi + 1] = bt[4 * gi + 1] * s1; a[4 * gi + 0] = bt[4 * gi + 0] * s0;
        const float gp = g[gi] * pg[gi];
        above *= gp; tp *= gp;
    }
    cl = above;
    carry += __builtin_amdgcn_logf(tp);
    pack_p(a, P);
}

struct MUnit { int kind, h, QT, reuse; };
__device__ __forceinline__ int munit_w0(const MUnit& u) { const int back = u.kind == 0 ? 192 : 128; const int w = u.QT * 256 - back; return w < 0 ? 0 : w; }
__device__ __forceinline__ const bf16_t* munit_kplane(const bf16_t* QKV, const MUnit& u) { return QKV + (size_t)(u.kind == 0 ? KB_OFF / 64 + u.h : KA_OFF / 64 + (u.h >> 2)) * M * 64; }
__device__ __forceinline__ const bf16_t* munit_vplane(const bf16_t* QKV, const MUnit& u) { return QKV + (size_t)(u.kind == 0 ? VB_OFF / 64 + u.h : VA_OFF / 64 + (u.h >> 2)) * M * 64; }
__device__ __forceinline__ void munit_issue(WinRegs& w, bf16x8 (&Bq)[4], const bf16_t* QKV, const MUnit& u, int wave, int lane) {
    const int W0 = munit_w0(u);
    if (!u.reuse) win_issue(w, munit_kplane(QKV, u), munit_vplane(QKV, u), W0, u.QT * 256 + 256 - W0, wave * 64 + lane);
    const bf16_t* qp = QKV + ((size_t)((u.kind == 0 ? QB_OFF : QA_OFF) / 64 + u.h) * M + u.QT * 256 + 32 * wave + (lane & 31)) * 64 + 8 * (lane >> 5);
#pragma unroll
    for (int kk = 0; kk < 4; ++kk) Bq[kk] = *(const bf16x8*)(qp + 16 * kk);
}

__device__ __forceinline__ void attn_b_compute(LAS unsigned char* lds, const bf16_t* QKV, bf16_t* ATT, const bf16x8 (&Bq)[4], int h, int QT, int wave, int lane) {
    const int q = lane & 31, hi = lane >> 5, T0 = QT * 256, t0 = T0 + 32 * wave;
    f32x16 O0, O1;
#pragma unroll
    for (int i = 0; i < 16; ++i) { O0[i] = 0.f; O1[i] = 0.f; }
    float carry = 0.f, cl = 1.f; bool done = false; int s0 = t0;
    volatile LAS unsigned* flag = (volatile LAS unsigned*)(lds + ATT_FLAG_OFF);
    int Whi = T0 + 256, W0 = T0 - 192 < 0 ? 0 : T0 - 192;
    for (;;) {
        while (!done && s0 >= W0) {
            const f32x16 S = qk_tile(lds, s0 - W0, Bq, q, hi);
            bf16x8 P[2];
            if (s0 == t0) sb_tile<true>(S, q, hi, carry, cl, P); else sb_tile<false>(S, q, hi, carry, cl, P);
            pv_acc(lds, s0 - W0, P, O0, O1, q, hi);
            if (__all(carry < SB_EXIT)) done = true;
            s0 -= 32;
        }
        if (s0 < 0) done = true;
        if (!done && lane == 0) flag[0] = 1u;
        __syncthreads();
        const bool any = flag[0] != 0u;
        if (!any || W0 == 0) break;
        __syncthreads();
        Whi = W0; W0 = W0 - WIN_KEYS < 0 ? 0 : W0 - WIN_KEYS;
        if (threadIdx.x == 0) flag[0] = 0u;
        { WinRegs w; win_issue(w, QKV + (size_t)(KB_OFF / 64 + h) * M * 64, QKV + (size_t)(VB_OFF / 64 + h) * M * 64, W0, Whi - W0, wave * 64 + lane); win_commit(lds, w, Whi - W0, wave * 64 + lane); }
        __syncthreads();
    }
    store_o(ATT + (size_t)(t0 + q) * D + 1024 + h * 64, O0, O1, 1.f, hi);
}

__device__ __forceinline__ void attn_a_compute(LAS unsigned char* lds, bf16_t* ATT, const bf16x8 (&Bq)[4], int h, int QT, int wave, int lane, float sink2, float slope2) {
    const int q = lane & 31, hi = lane >> 5, T0 = QT * 256, t0 = T0 + 32 * wave;
    f32x16 O0, O1;
#pragma unroll
    for (int i = 0; i < 16; ++i) { O0[i] = 0.f; O1[i] = 0.f; }
    float mrun = sink2, lrun = 1.f;
    const int W0 = T0 - 128 < 0 ? 0 : T0 - 128;
    for (int s0 = (t0 - 128 < 0 ? 0 : t0 - 128); s0 <= t0; s0 += 32) {
        const f32x16 S = qk_tile(lds, s0 - W0, Bq, q, hi);
        const int dq = t0 - s0 + q;
        float s[16]; float mx = -INFINITY;
#pragma unroll
        for (int i = 0; i < 16; ++i) { const int dist = dq - (8 * (i >> 2) + 4 * hi + (i & 3));
            s[i] = ((unsigned)dist < 128u) ? S[i] - slope2 * (float)dist : -INFINITY; mx = fmaxf(mx, s[i]); }
        mx = fmaxf(mx, __shfl_xor(mx, 32));
        const float mnew = fmaxf(mrun, mx), alpha = __builtin_amdgcn_exp2f(mrun - mnew);
        float a[16]; float rs = 0.f;
#pragma unroll
        for (int i = 0; i < 16; ++i) { a[i] = __builtin_amdgcn_exp2f(s[i] - mnew); rs += a[i]; }
        rs += __shfl_xor(rs, 32);
        lrun = lrun * alpha + rs; mrun = mnew;
#pragma unroll
        for (int i = 0; i < 16; ++i) { O0[i] *= alpha; O1[i] *= alpha; }
        bf16x8 P[2];
        pack_p(a, P);
        pv_acc(lds, s0 - W0, P, O0, O1, q, hi);
    }
    __syncthreads();
    store_o(ATT + (size_t)(t0 + q) * D + h * 64, O0, O1, 1.f / lrun, hi);
}

__device__ __forceinline__ bool munit_get(int j, int G, MUnit& u) {
    const int b = (int)blockIdx.x, nper = b < 512 ? (512 - b + G - 1) / G : 0;
    if (j >= 2 * nper) return false;
    const int kind = j >= nper ? 1 : 0, uu = b + (j - kind * nper) * G;
    u.kind = kind; u.h = uu >> 5; u.QT = uu & 31; u.reuse = 0;
    if (kind == 1 && G == 256) { const int jj = j - nper; u.h = 2 * (b >> 5) + jj; u.QT = b & 31; u.reuse = jj; }
    return true;
}
__device__ __forceinline__ void mixer_phase(LAS unsigned char* lds, const bf16_t* QKV, bf16_t* ATT, const float* sinks, int G, int wave, int lane) {
    MUnit cur, nxt;
    if (!munit_get(0, G, cur)) return;
    WinRegs w; bf16x8 Bqn[4];
    munit_issue(w, Bqn, QKV, cur, wave, lane);
    for (int j = 0;; ++j) {
        bf16x8 Bq[4];
#pragma unroll
        for (int kk = 0; kk < 4; ++kk) Bq[kk] = Bqn[kk];
        if (!cur.reuse) {
            win_commit(lds, w, cur.QT * 256 + 256 - munit_w0(cur), wave * 64 + lane);
            if (threadIdx.x == 0) *(volatile LAS unsigned*)(lds + ATT_FLAG_OFF) = 0u;
            __syncthreads();
        }
        const bool has_next = munit_get(j + 1, G, nxt);
        if (has_next) munit_issue(w, Bqn, QKV, nxt, wave, lane);
        if (cur.kind == 0) attn_b_compute(lds, QKV, ATT, Bq, cur.h, cur.QT, wave, lane);
        else attn_a_compute(lds, ATT, Bq, cur.h, cur.QT, wave, lane, sinks[cur.h] * LOG2E, __builtin_amdgcn_exp2f(-0.5f * (float)(cur.h + 1)) * LOG2E);
        if (!has_next) break;
        cur = nxt;
    }
}

__device__ __forceinline__ float wave_sum(float v) {
#pragma unroll
    for (int o = 1; o < 64; o <<= 1) v += __shfl_xor(v, o);
    return v;
}
struct TItem { const float* src; bf16_t* dst; const float* ks; int N, ldT; float cs; };
__device__ __forceinline__ TItem p0_decode(int it, int lane, const float* w_in, const float* w_a, const float* w_b, const float* w_out, const float* w_ffn, const float* w_dn, const float* g_ffn,
                                           bf16_t* Win_t, bf16_t* Wab_t, bf16_t* Wout_t, bf16_t* Wffn_t, bf16_t* Wdn_t) {
    constexpr int I_IN = (D / 64) * (INW / 32), I_AB = (1024 / 64) * (D / 32), I_OUT = (D / 64) * (D / 32), I_FFN = (D / 64) * (FF2 / 32);
    const int g = lane & 7, nq = lane >> 3;
    const float* W; bf16_t* WT; int N, ldT, nb, orow_adj = 0; float cs = 1.f; const float* ks = nullptr; int r = it; int mode = 0;
    if (r < I_IN) { W = w_in; WT = Win_t; N = INW; ldT = D; mode = 1; }
    else if ((r -= I_IN) < I_AB) { W = w_a; WT = Wab_t; N = D; ldT = 1024; }
    else if ((r -= I_AB) < I_AB) { W = w_b; WT = Wab_t + (size_t)D * 1024; N = D; ldT = 1024; }
    else if ((r -= I_AB) < I_OUT) { W = w_out; WT = Wout_t; N = D; ldT = D; }
    else if ((r -= I_OUT) < I_FFN) { W = w_ffn; WT = Wffn_t; N = FF2; ldT = D; mode = 2; ks = g_ffn; }
    else { r -= I_FFN; W = w_dn; WT = Wdn_t; N = D; ldT = FF; }
    nb = N / 32; const int kb = r / nb, n0 = (r - kb * nb) * 32, k0 = kb * 64;
    int orow = n0;
    if (mode == 1) cs = (n0 < 1024 || (n0 >= QB_OFF && n0 < KB_OFF)) ? QSCALE : 1.f;
    if (mode == 2) { const int up = n0 >= FF, nn = up ? n0 - FF : n0; orow = (nn >> 7) * 256 + up * 128 + (nn & 127); }
    (void)orow_adj;
    TItem t; t.src = W + (size_t)(k0 + 8 * g) * N + n0 + 4 * nq; t.dst = WT + (size_t)(orow + 4 * nq) * ldT + k0 + 8 * g; t.ks = ks ? ks + k0 + 8 * g : nullptr; t.N = N; t.ldT = ldT; t.cs = cs;
    return t;
}
__device__ __forceinline__ void p0_load(const TItem& t, f32x4 (&v)[8]) {
#pragma unroll
    for (int kk = 0; kk < 8; ++kk) v[kk] = __builtin_nontemporal_load((const f32x4*)(t.src + (size_t)kk * t.N));
}
__device__ __forceinline__ void p0_store(const TItem& t, const f32x4 (&v)[8]) {
    float sc[8];
    if (t.ks) { const f32x4 a = *(const f32x4*)t.ks, b = *(const f32x4*)(t.ks + 4); sc[0] = a[0]; sc[1] = a[1]; sc[2] = a[2]; sc[3] = a[3]; sc[4] = b[0]; sc[5] = b[1]; sc[6] = b[2]; sc[7] = b[3]; }
    else {
#pragma unroll
        for (int kk = 0; kk < 8; ++kk) sc[kk] = 1.f; }
#pragma unroll
    for (int kk = 0; kk < 8; ++kk) sc[kk] *= t.cs;
#pragma unroll
    for (int j = 0; j < 4; ++j) { u32x4 o; o.x = pk2(v[0][j] * sc[0], v[1][j] * sc[1]); o.y = pk2(v[2][j] * sc[2], v[3][j] * sc[3]); o.z = pk2(v[4][j] * sc[4], v[5][j] * sc[5]); o.w = pk2(v[6][j] * sc[6], v[7][j] * sc[7]);
        *(u32x4*)(t.dst + (size_t)j * t.ldT) = o; }
}
__device__ __forceinline__ void norm_row_load(const float* x, int m, int lane, f32x4 (&v)[8]) {
    const f32x4* xr = (const f32x4*)(x + (size_t)m * D) + lane;
#pragma unroll
    for (int j = 0; j < 8; ++j) v[j] = __builtin_nontemporal_load(xr + 64 * j);
}
__device__ __forceinline__ float norm_row_inv(const f32x4 (&v)[8]) {
    float s = 0.f;
#pragma unroll
    for (int j = 0; j < 8; ++j) s += (v[j][0] * v[j][0] + v[j][1] * v[j][1]) + (v[j][2] * v[j][2] + v[j][3] * v[j][3]);
    return rsqrtf(wave_sum(s) * (1.f / D) + EPS);
}

#define XB_TMO      128
#define XB_XCNT(j)  (256  + 64 * (j))
#define XB_XSUB(j)  (1280 + 64 * (j))
#define XB_XGEN(j)  (2304 + 64 * (j))
#define XB_TOP      3328
#define XB_TOPGEN   3392
#define XCD_BAR_WORDS 3456
#define XB_SPIN_CAP (1u << 18)
__device__ __forceinline__ unsigned xb_ld(unsigned* p)              { return __hip_atomic_load(p, __ATOMIC_RELAXED, __HIP_MEMORY_SCOPE_AGENT); }
__device__ __forceinline__ unsigned xb_add(unsigned* p, unsigned v) { return __hip_atomic_fetch_add(p, v, __ATOMIC_RELAXED, __HIP_MEMORY_SCOPE_AGENT); }
__device__ __forceinline__ unsigned xb_xcc_id() { return (unsigned)__builtin_amdgcn_s_getreg((3 << 11) | 20) & 0xFu; }
#define XB_SPIN(cond, bar) do { unsigned _sp = 0; while (cond) { __builtin_amdgcn_s_sleep(1); \
    if ((++_sp & 255u) == 0u) { if (xb_ld(&(bar)[XB_TMO])) break; if (_sp > XB_SPIN_CAP) { atomicAdd(&(bar)[XB_TMO], 1u); break; } } } } while (0)
struct XcdBarrier { unsigned* bar; unsigned x; volatile LAS unsigned* st; };
__device__ __forceinline__ XcdBarrier xcd_barrier_post(unsigned* bar, volatile LAS unsigned* st) {
    XcdBarrier b; b.bar = bar; b.x = xb_xcc_id(); b.st = st;
    if (threadIdx.x == 0) (void)xb_add(&bar[XB_XCNT(b.x)], 1u);
    return b;
}
__device__ __forceinline__ void xcd_barrier_complete(unsigned* bar, unsigned x, unsigned& nloc, unsigned& nx) {
    const unsigned G = gridDim.x * gridDim.y * gridDim.z;
    unsigned sum, cnt, mine, sp = 0u;
    for (;;) {
        sum = 0u; cnt = 0u; mine = 0u;
#pragma unroll
        for (unsigned j = 0; j < 16; ++j) { const unsigned c = xb_ld(&bar[XB_XCNT(j)]); sum += c; cnt += (c > 0u) ? 1u : 0u; mine = (j == x) ? c : mine; }
        if (sum == G) break;
        __builtin_amdgcn_s_sleep(1);
        if ((++sp & 255u) == 0u) { if (xb_ld(&bar[XB_TMO])) break; if (sp > XB_SPIN_CAP) { atomicAdd(&bar[XB_TMO], 1u); break; } }
    }
    nloc = mine > 0u ? mine : 1u; nx = cnt > 0u ? cnt : 1u;
}
__device__ __forceinline__ void xcd_barrier(const XcdBarrier& b) {
    asm volatile("s_waitcnt vmcnt(0)" ::: "memory");
    __syncthreads();
    if (threadIdx.x == 0) {
        unsigned* bar = b.bar;
        __builtin_amdgcn_s_waitcnt(0);
        unsigned nloc = b.st[0], nx = b.st[1];
        if (nloc == 0u) { xcd_barrier_complete(bar, b.x, nloc, nx); b.st[0] = nloc; b.st[1] = nx; }
        const unsigned old = xb_add(&bar[XB_XSUB(b.x)], 1u);
        const unsigned gen = old / nloc;
        if (old + 1u == (gen + 1u) * nloc) {
            __builtin_amdgcn_fence(__ATOMIC_RELEASE, "agent");
            asm volatile("s_waitcnt vmcnt(0)" ::: "memory");
            const unsigned og = xb_add(&bar[XB_TOP], 1u);
            const unsigned tg = og / nx;
            if (og + 1u == (tg + 1u) * nx) xb_add(&bar[XB_TOPGEN], 1u);
            else XB_SPIN(xb_ld(&bar[XB_TOPGEN]) == tg, bar);
            __builtin_amdgcn_fence(__ATOMIC_ACQUIRE, "agent");
            xb_add(&bar[XB_XGEN(b.x)], 1u);
            asm volatile("s_waitcnt vmcnt(0)" ::: "memory");
        } else {
            XB_SPIN(xb_ld(&bar[XB_XGEN(b.x)]) == gen, bar);
            __builtin_amdgcn_fence(__ATOMIC_ACQUIRE, "agent");
            asm volatile("s_waitcnt vmcnt(0)" ::: "memory");
        }
    }
    __syncthreads();
}

constexpr int I_IN = (D / 64) * (INW / 32), I_AB = (1024 / 64) * (D / 32), I_OUT = (D / 64) * (D / 32), I_FFN = (D / 64) * (FF2 / 32), I_DN = (FF / 64) * (D / 32);
constexpr int IT_P1_LO = I_IN, IT_P1_HI = I_IN + 2 * I_AB + I_OUT + I_FFN, IT_END = IT_P1_HI + I_DN;
#define CONVERT_ITEMS(lo_, hi_, widx_, nw_) do { \
    for (int it = (lo_) + (widx_); it < (hi_); it += 4 * (nw_)) { \
        const bool hasb = it + (nw_) < (hi_), hasc = it + 2 * (nw_) < (hi_), hasd = it + 3 * (nw_) < (hi_); \
        const TItem ta = p0_decode(it, lane, w_in, w_a, w_b, w_out, w_ffn, w_dn, g_ffn, Win_t, Wab_t, Wout_t, Wffn_t, Wdn_t); \
        const TItem tb = p0_decode(hasb ? it + (nw_) : it, lane, w_in, w_a, w_b, w_out, w_ffn, w_dn, g_ffn, Win_t, Wab_t, Wout_t, Wffn_t, Wdn_t); \
        const TItem tc = p0_decode(hasc ? it + 2 * (nw_) : it, lane, w_in, w_a, w_b, w_out, w_ffn, w_dn, g_ffn, Win_t, Wab_t, Wout_t, Wffn_t, Wdn_t); \
        const TItem td = p0_decode(hasd ? it + 3 * (nw_) : it, lane, w_in, w_a, w_b, w_out, w_ffn, w_dn, g_ffn, Win_t, Wab_t, Wout_t, Wffn_t, Wdn_t); \
        f32x4 va[8], vb[8], vc[8], vd[8]; \
        p0_load(ta, va); p0_load(tb, vb); p0_load(tc, vc); p0_load(td, vd); \
        p0_store(ta, va); if (hasb) p0_store(tb, vb); if (hasc) p0_store(tc, vc); if (hasd) p0_store(td, vd); \
    } } while (0)

struct Args { const float* in[11]; float* out; unsigned char* ws; int ph_lo, ph_hi; };

__global__ void __launch_bounds__(512, 2) fwd_megakernel(Args args) {
    extern __shared__ __attribute__((aligned(16))) unsigned char lds_raw[];
    LAS unsigned char* lds = (LAS unsigned char*)lds_raw;
    cg::grid_group grid = cg::this_grid();
    const int tid = threadIdx.x, lane = tid & 63, wave = __builtin_amdgcn_readfirstlane(tid >> 6);
    const int G = gridDim.x, gw = blockIdx.x * 8 + wave, NGW = G * 8;
    const int lo = args.ph_lo, hi = args.ph_hi;
    const bool fusedfin = (G == 256) && (MK_N_LAUNCHES == 1);
    unsigned char* ws = args.ws;
    const float* x = args.in[0]; const float* g_mix = args.in[1]; const float* w_in = args.in[2]; const float* sinks = args.in[3];
    const float* w_a = args.in[4]; const float* w_b = args.in[5]; const float* w_out = args.in[6]; const float* g_ffn = args.in[7];
    const float* w_ffn = args.in[8]; const float* w_dn = args.in[9]; const float* g_fin = args.in[10];
    float* out = args.out;
    bf16_t* Win_t = (bf16_t*)(ws + WS_WIN); bf16_t* Wab_t = (bf16_t*)(ws + WS_WAB); bf16_t* Wout_t = (bf16_t*)(ws + WS_WOUT);
    bf16_t* Wffn_t = (bf16_t*)(ws + WS_WFFN); bf16_t* Wdn_t = (bf16_t*)(ws + WS_WDN);
    bf16_t* XN = (bf16_t*)(ws + WS_XN); bf16_t* MRG = XN; bf16_t* ATT = (bf16_t*)(ws + WS_ATT); bf16_t* X1B = ATT;
    bf16_t* QKV = (bf16_t*)(ws + WS_PROJ); bf16_t* GB = (bf16_t*)(ws + WS_PROJ + 72 * MiB); bf16_t* H = QKV; float* RSQ = (float*)(ws + WS_RSQ);
#define IN(k) (lo <= (k) && (k) < hi)
#ifdef PROBE_PH
#define PH_BEGIN(k) if (IN(k)) for (int rep_ = 0; rep_ < ((k) == PROBE_PH ? 2 : 1); ++rep_, ((k) == PROBE_PH && rep_ == 1) ? xcd_barrier(bar) : (void)0)
#else
#define PH_BEGIN(k) if (IN(k))
#endif
#define SEAM(k) do { if (IN(k) && IN((k) + 1)) xcd_barrier(bar); } while (0)
    if (args.ph_lo < 0) grid.sync();
    if (tid < 8) ((LAS unsigned*)(lds + 131072))[tid] = 0u;
    __syncthreads();
    const XcdBarrier bar = xcd_barrier_post((unsigned*)(ws + WS_CTL), (volatile LAS unsigned*)(lds + 131072));

    PH_BEGIN(0) {
        CONVERT_ITEMS(0, I_IN, gw, NGW);
        f32x4 gmix[8];
#pragma unroll
        for (int j = 0; j < 8; ++j) gmix[j] = ((const f32x4*)g_mix + lane)[64 * j];
        for (int m = gw; m < M; m += 2 * NGW) {
            const int m2 = m + NGW;
            const bool has2 = m2 < M;
            f32x4 va[8], vb[8];
            norm_row_load(x, m, lane, va); norm_row_load(x, has2 ? m2 : m, lane, vb);
            const float ia = norm_row_inv(va), ib = norm_row_inv(vb);
            u32x2* oa = (u32x2*)(XN + (size_t)m * D) + lane; u32x2* ob = (u32x2*)(XN + (size_t)m2 * D) + lane;
#pragma unroll
            for (int j = 0; j < 8; ++j) { const f32x4 gg = gmix[j];
                u32x2 w; w.x = pk2(va[j][0] * ia * gg[0], va[j][1] * ia * gg[1]); w.y = pk2(va[j][2] * ia * gg[2], va[j][3] * ia * gg[3]); oa[64 * j] = w;
                if (has2) { u32x2 w2; w2.x = pk2(vb[j][0] * ib * gg[0], vb[j][1] * ib * gg[1]); w2.y = pk2(vb[j][2] * ib * gg[2], vb[j][3] * ib * gg[3]); ob[64 * j] = w2; } }
        }
    }
    SEAM(0);
    PH_BEGIN(1) {
        pg8::Gemm g{XN, Win_t, D, D, D, 0, 0}; pg8::StaticOrder S; S.init(M, INW, G, (int)blockIdx.x, 1);
        pg8::EpiProj E{QKV, GB};
        pg8::gemm_phase<pg8::EpiProj, true>(lds, g, S, E);
        { const int rem = S.nwg % G; if (rem && (int)blockIdx.x >= rem) CONVERT_ITEMS(IT_P1_LO, IT_P1_HI, ((int)blockIdx.x - rem) * 8 + wave, (G - rem) * 8);
          else if (!rem) CONVERT_ITEMS(IT_P1_LO, IT_P1_HI, gw, NGW); }
    }
    SEAM(1);
    PH_BEGIN(2) {
        mixer_phase(lds, QKV, ATT, sinks, G, wave, lane);
    }
    SEAM(2);
    PH_BEGIN(3) {
        pg8::Gemm g{ATT, Wab_t, D, 1024, 1024, (size_t)1024 * 2, (size_t)D * 1024 * 2}; pg8::StaticOrder S; S.init(M, D, G, (int)blockIdx.x, 2);
        pg8::EpiBranch E{GB, out, MRG};
        pg8::gemm_phase<pg8::EpiBranch, true>(lds, g, S, E);
    }
    SEAM(3);
    PH_BEGIN(4) {
        pg8::Gemm g{MRG, Wout_t, D, D, D, 0, 0}; pg8::StaticOrder S; S.init(M, D, G, (int)blockIdx.x, 1);
        if (fusedfin) { pg8::EpiRes1F E{x, X1B, RSQ, (float*)(ws + WS_CTL + 65536 + 262144), (unsigned*)(ws + WS_CTL + 16384), (unsigned*)(ws + WS_CTL) + XB_TMO};
            pg8::gemm_phase<pg8::EpiRes1F, false>(lds, g, S, E); }
        else { pg8::EpiRes1 E{x, out, X1B, RSQ, true};
            pg8::gemm_phase<pg8::EpiRes1, false>(lds, g, S, E); }
    }
    SEAM(4);
    PH_BEGIN(5) {
        pg8::Gemm g{X1B, Wffn_t, D, D, D, 0, 0}; pg8::StaticOrder S; S.init(M, FF2, G, (int)blockIdx.x, 1);
        if (fusedfin) { pg8::EpiSwigluN E{H};
            pg8::gemm_phase<pg8::EpiSwigluN, true>(lds, g, S, E); }
        else { pg8::EpiSwiglu E{RSQ, H};
            pg8::gemm_phase<pg8::EpiSwiglu, true>(lds, g, S, E); }
        { const int rem = S.nwg % G; if (rem && (int)blockIdx.x >= rem) CONVERT_ITEMS(IT_P1_HI, IT_END, ((int)blockIdx.x - rem) * 8 + wave, (G - rem) * 8);
          else if (!rem) CONVERT_ITEMS(IT_P1_HI, IT_END, gw, NGW); }
    }
    SEAM(5);
    PH_BEGIN(6) {
        pg8::Gemm g{H, Wdn_t, FF, FF, FF, 0, 0}; pg8::StaticOrder S; S.init(M, D, G, (int)blockIdx.x, 1);
        if (fusedfin) { pg8::EpiFinal E{X1B, RSQ, out, g_fin, (float*)(ws + WS_CTL + 65536), (unsigned*)(ws + WS_CTL + 14336), (unsigned*)(ws + WS_CTL) + XB_TMO};
            pg8::gemm_phase<pg8::EpiFinal, false>(lds, g, S, E); }
        else { pg8::EpiRes2 E{out};
            pg8::gemm_phase<pg8::EpiRes2, false>(lds, g, S, E); }
    }
    if (!fusedfin) SEAM(6);
    PH_BEGIN(7) { if (!fusedfin)
        for (int m = gw; m < M; m += NGW) {
            f32x4* xr = (f32x4*)(out + (size_t)m * D) + lane; const f32x4* gr = (const f32x4*)g_fin + lane;
            f32x4 v[8]; float s = 0.f;
#pragma unroll
            for (int j = 0; j < 8; ++j) { v[j] = xr[64 * j]; s += (v[j][0] * v[j][0] + v[j][1] * v[j][1]) + (v[j][2] * v[j][2] + v[j][3] * v[j][3]); }
            const float inv = rsqrtf(wave_sum(s) * (1.f / D) + EPS);
#pragma unroll
            for (int j = 0; j < 8; ++j) { const f32x4 gg = gr[64 * j]; xr[64 * j] = v[j] * inv * gg; }
        }
    }
#undef IN
#undef SEAM
}

extern "C" void kernel_launch(void* const* d_in, const int* in_sizes, int n_in, void* d_out, int out_size, void* d_ws, size_t ws_size, hipStream_t stream) {
    static int grid = 0;
    if (grid == 0) {
        if (n_in != 11 || in_sizes[0] != M * D || out_size != M * D || ws_size < WS_END) { fprintf(stderr, "kernel_launch: unexpected sizes (n_in %d, in0 %d, out %d, ws %zu)\n", n_in, n_in > 0 ? in_sizes[0] : -1, out_size, ws_size); grid = -1; return; }
        int dev = 0, cus = 0, per_cu = 0;
        if (hipGetDevice(&dev) != hipSuccess || hipDeviceGetAttribute(&cus, hipDeviceAttributeMultiprocessorCount, dev) != hipSuccess) { grid = -1; return; }
        if (hipFuncSetAttribute((const void*)fwd_megakernel, hipFuncAttributeMaxDynamicSharedMemorySize, LDS_BYTES) != hipSuccess) { fprintf(stderr, "kernel_launch: hipFuncSetAttribute failed\n"); grid = -1; return; }
        if (hipOccupancyMaxActiveBlocksPerMultiprocessor(&per_cu, (const void*)fwd_megakernel, 512, LDS_BYTES) != hipSuccess || per_cu < 1) { fprintf(stderr, "kernel_launch: occupancy query says %d\n", per_cu); per_cu = 1; }
        (void)hipGetLastError();
        grid = cus * 1;
    }
    if (grid < 0) return;
    (void)hipMemsetAsync((char*)d_ws + WS_CTL, 0, CTL_BYTES, stream);
    Args a{};
    for (int i = 0; i < 11; ++i) a.in[i] = (const float*)d_in[i];
    a.out = (float*)d_out; a.ws = (unsigned char*)d_ws;
#if MK_N_LAUNCHES == 1
    a.ph_lo = 0; a.ph_hi = NPH;
    void* kargs[] = {&a};
    hipError_t e = hipLaunchCooperativeKernel((const void*)fwd_megakernel, dim3(grid), dim3(512), kargs, LDS_BYTES, stream);
    if (e != hipSuccess) fprintf(stderr, "kernel_launch: cooperative launch failed: %s (grid %d)\n", hipGetErrorString(e), grid);
#else
    for (int p = 0; p < NPH; ++p) {
        a.ph_lo = p; a.ph_hi = p + 1;
        hipLaunchKernelGGL(fwd_megakernel, dim3(grid), dim3(512), LDS_BYTES, stream, a);
#ifdef PROBE_DUP
        if (p == PROBE_DUP) hipLaunchKernelGGL(fwd_megakernel, dim3(grid), dim3(512), LDS_BYTES, stream, a);
#endif
    }
#endif
}
```

```cpp
#include <hip/hip_runtime.h>
#include <hip/hip_cooperative_groups.h>
#include <cstdio>
#include <cstdint>
namespace cg = cooperative_groups;

#ifndef MK_N_LAUNCHES
#define MK_N_LAUNCHES 1
#endif

#define LAS __attribute__((address_space(3)))
typedef unsigned short bf16_t;
typedef short bf16x8 __attribute__((ext_vector_type(8)));
typedef short s16x4 __attribute__((ext_vector_type(4)));
typedef float f32x2 __attribute__((ext_vector_type(2)));
typedef float f32x4 __attribute__((ext_vector_type(4)));
typedef float f32x16 __attribute__((ext_vector_type(16)));
typedef unsigned u32x2 __attribute__((ext_vector_type(2)));
typedef unsigned u32x4 __attribute__((ext_vector_type(4)));
typedef __bf16 bfv2 __attribute__((ext_vector_type(2)));

constexpr int M = 8192, D = 2048, INW = 8704, FF = 5632, FF2 = 11264;
constexpr int QA_OFF = 0, KA_OFF = 1024, VA_OFF = 1280, QB_OFF = 1536, KB_OFF = 2560, VB_OFF = 3584, GA_OFF = 4608, GB_OFF = 6656;
constexpr float EPS = 1e-6f, LOG2E = 1.4426950408889634f, QSCALE = 0.125f * LOG2E;
constexpr int NPH = 8;
constexpr size_t MiB = 1u << 20;
constexpr size_t WS_WIN = 0, WS_WAB = 34 * MiB, WS_WOUT = 42 * MiB, WS_WFFN = 50 * MiB, WS_WDN = 94 * MiB;
constexpr size_t WS_XN = 116 * MiB;
constexpr size_t WS_ATT = 148 * MiB;
constexpr size_t WS_PROJ = 180 * MiB;
constexpr size_t WS_RSQ = 316 * MiB, WS_CTL = 317 * MiB, CTL_BYTES = 20480, WS_END = 318 * MiB;
constexpr int LDS_BYTES = 131072 + 1024;

__device__ __forceinline__ unsigned pk2(float lo, float hi) { f32x2 v = {lo, hi}; return __builtin_bit_cast(unsigned, __builtin_convertvector(v, bfv2)); }
__device__ __forceinline__ float bflo(unsigned w) { return __builtin_bit_cast(float, w << 16); }
__device__ __forceinline__ float bfhi(unsigned w) { return __builtin_bit_cast(float, w & 0xffff0000u); }
__device__ __forceinline__ float fsigmoid(float g) { return __builtin_amdgcn_rcpf(1.f + __builtin_amdgcn_exp2f(-g * LOG2E)); }

namespace pg8 {
constexpr int BM = 256, BK = 64, HALF = 128, HTB = HALF * BK * 2, STAGE_BYTES = 8 * HTB, NXCD = 8, WGM = 8;
__device__ __forceinline__ int lds_byte(int r, int c) { const int st = (r >> 4) * 2 + (c >> 5), rr = r & 15, cc = c & 31, ob = rr * 64 + cc * 2; return st * 1024 + (ob ^ (((ob >> 9) & 1) << 5)); }
__device__ __forceinline__ void stage_rc(int b, int& R, int& C) { const int st = b / 1024, sb = b % 1024, swz = sb ^ (((sb >> 9) & 1) << 5); R = (st >> 1) * 16 + swz / 64; C = (st & 1) * 32 + (swz % 64) / 2; }
__device__ __forceinline__ int perm32(int rho) { const int n = rho >> 4, i = rho & 15; return 8 * (i >> 2) + 4 * n + (i & 3); }

struct Unit { int pm, pn, z; };
struct Gemm { const bf16_t* A; const bf16_t* Bt; int lda, ldb, K; size_t zoffA, zoffB; };

struct StaticOrder {
    int nM, nN, nwg, G, c, nz;
    __device__ void init(int M_, int N_, int G_, int c_, int nz_) { nM = M_ / BM; nN = N_ / BM; nwg = nM * nN; G = G_; c = c_; nz = nz_; }
    __device__ bool next(int i, Unit& u) const {
        const int ti = i / nz; u.z = i - ti * nz;
        const long L = (long)ti * G + c; if (L >= nwg) return false;
        int wgid = (int)L; { const int q = nwg / NXCD, r = nwg % NXCD, xcd = wgid % NXCD, off = wgid / NXCD; wgid = (xcd < r ? xcd * (q + 1) : r * (q + 1) + (xcd - r) * q) + off; }
        const int nig = WGM * nN, gid = wgid / nig, fm = gid * WGM, gsz = (nM - fm) < WGM ? (nM - fm) : WGM;
        u.pm = fm + ((wgid % nig) % gsz); u.pn = (wgid % nig) / gsz; return true;
    }
};

#define EPI_ROW(u, ai, m) ((u).pm * 256 + (ai) * 128 + wr * 64 + (m) * 16 + fr)
#define EPI_COL(u, bj) ((u).pn * 256 + (bj) * 128 + wc * 32 + 8 * fq)

struct EpiStoreBf16 {
    static constexpr bool AFTER_DRAIN = false;
    bf16_t* O; int ldc;
    __device__ __forceinline__ void operator()(const f32x4 (&acc)[2][2][4][2], const Unit& u, int wr, int wc, int fr, int fq) const {
#pragma unroll
        for (int ai = 0; ai < 2; ++ai)
#pragma unroll
            for (int m = 0; m < 4; ++m) { bf16_t* rowp = O + (size_t)EPI_ROW(u, ai, m) * ldc;
#pragma unroll
                for (int bj = 0; bj < 2; ++bj) { const f32x4 v0 = acc[ai][bj][m][0], v1 = acc[ai][bj][m][1];
                    u32x4 w; w.x = pk2(v0[0], v0[1]); w.y = pk2(v0[2], v0[3]); w.z = pk2(v1[0], v1[1]); w.w = pk2(v1[2], v1[3]);
                    *(u32x4*)(rowp + EPI_COL(u, bj)) = w; } }
    }
};
struct EpiProj {
    static constexpr bool AFTER_DRAIN = false;
    bf16_t* QKV; bf16_t* Gb;
    __device__ __forceinline__ void operator()(const f32x4 (&acc)[2][2][4][2], const Unit& u, int wr, int wc, int fr, int fq) const {
        const bool isg = u.pn >= 18;
#pragma unroll
        for (int ai = 0; ai < 2; ++ai)
#pragma unroll
            for (int m = 0; m < 4; ++m) { const int r = EPI_ROW(u, ai, m);
#pragma unroll
                for (int bj = 0; bj < 2; ++bj) { const int c = EPI_COL(u, bj); const f32x4 v0 = acc[ai][bj][m][0], v1 = acc[ai][bj][m][1];
                    u32x4 w; w.x = pk2(v0[0], v0[1]); w.y = pk2(v0[2], v0[3]); w.z = pk2(v1[0], v1[1]); w.w = pk2(v1[2], v1[3]);
                    bf16_t* dst = isg ? Gb + (size_t)r * 4096 + (c - GA_OFF) : QKV + ((size_t)(c >> 6) * M + r) * 64 + (c & 63);
                    *(u32x4*)dst = w; } }
    }
};
struct EpiBranch {
    static constexpr bool AFTER_DRAIN = false;
    const bf16_t* Gb; float* T; bf16_t* MRG;
    __device__ __forceinline__ void operator()(const f32x4 (&acc)[2][2][4][2], const Unit& u, int wr, int wc, int fr, int fq) const {
        const int goff = (u.z == 0) ? 0 : 2048;
#pragma unroll
        for (int ai = 0; ai < 2; ++ai) {
            u32x4 gw[4][2], tw[4][2];
#pragma unroll
            for (int m = 0; m < 4; ++m)
#pragma unroll
                for (int bj = 0; bj < 2; ++bj) gw[m][bj] = *(const u32x4*)(Gb + (size_t)EPI_ROW(u, ai, m) * 4096 + goff + EPI_COL(u, bj));
            if (u.z != 0) {
#pragma unroll
                for (int m = 0; m < 4; ++m)
#pragma unroll
                    for (int bj = 0; bj < 2; ++bj) tw[m][bj] = *(const u32x4*)((const bf16_t*)T + (size_t)EPI_ROW(u, ai, m) * D + EPI_COL(u, bj));
            }
#pragma unroll
            for (int m = 0; m < 4; ++m) { const int r = EPI_ROW(u, ai, m);
#pragma unroll
                for (int bj = 0; bj < 2; ++bj) { const int c = EPI_COL(u, bj); const u32x4 g = gw[m][bj];
                    f32x4 v0 = acc[ai][bj][m][0], v1 = acc[ai][bj][m][1];
                    v0[0] *= fsigmoid(bflo(g.x)); v0[1] *= fsigmoid(bfhi(g.x)); v0[2] *= fsigmoid(bflo(g.y)); v0[3] *= fsigmoid(bfhi(g.y));
                    v1[0] *= fsigmoid(bflo(g.z)); v1[1] *= fsigmoid(bfhi(g.z)); v1[2] *= fsigmoid(bflo(g.w)); v1[3] *= fsigmoid(bfhi(g.w));
                    if (u.z != 0) { const u32x4 t = tw[m][bj];
                        v0[0] += bflo(t.x); v0[1] += bfhi(t.x); v0[2] += bflo(t.y); v0[3] += bfhi(t.y); v1[0] += bflo(t.z); v1[1] += bfhi(t.z); v1[2] += bflo(t.w); v1[3] += bfhi(t.w); }
                    u32x4 w; w.x = pk2(v0[0], v0[1]); w.y = pk2(v0[2], v0[3]); w.z = pk2(v1[0], v1[1]); w.w = pk2(v1[2], v1[3]);
                    if (u.z == 0) *(u32x4*)((bf16_t*)T + (size_t)r * D + c) = w;
                    else *(u32x4*)(MRG + (size_t)r * D + c) = w; } }
        }
    }
};
struct EpiRes1 {
    static constexpr bool AFTER_DRAIN = false;
    const float* x; float* x1; bf16_t* x1b; float* rsq; bool write_f32;
    __device__ __forceinline__ void operator()(const f32x4 (&acc)[2][2][4][2], const Unit& u, int wr, int wc, int fr, int fq) const {
#pragma unroll
        for (int ai = 0; ai < 2; ++ai)
#pragma unroll
            for (int m = 0; m < 4; ++m) { const int r = EPI_ROW(u, ai, m); float ss = 0.f;
#pragma unroll
                for (int bj = 0; bj < 2; ++bj) { const int c = EPI_COL(u, bj); const size_t off = (size_t)r * D + c;
                    const f32x4 v0 = acc[ai][bj][m][0] + *(const f32x4*)(x + off), v1 = acc[ai][bj][m][1] + *(const f32x4*)(x + off + 4);
                    if (write_f32) { *(f32x4*)(x1 + off) = v0; *(f32x4*)(x1 + off + 4) = v1; }
                    ss += (v0[0] * v0[0] + v0[1] * v0[1]) + (v0[2] * v0[2] + v0[3] * v0[3]) + (v1[0] * v1[0] + v1[1] * v1[1]) + (v1[2] * v1[2] + v1[3] * v1[3]);
                    u32x4 w; w.x = pk2(v0[0], v0[1]); w.y = pk2(v0[2], v0[3]); w.z = pk2(v1[0], v1[1]); w.w = pk2(v1[2], v1[3]);
                    *(u32x4*)(x1b + off) = w; }
                ss += __shfl_xor(ss, 16); ss += __shfl_xor(ss, 32);
                if (fq == 0) rsq[(size_t)r * 32 + u.pn * 4 + wc] = ss; }
    }
};
struct EpiSwiglu {
    static constexpr bool AFTER_DRAIN = false;
    const float* rsq; bf16_t* H;
    __device__ __forceinline__ void operator()(const f32x4 (&acc)[2][2][4][2], const Unit& u, int wr, int wc, int fr, int fq) const {
#pragma unroll
        for (int ai = 0; ai < 2; ++ai)
#pragma unroll
            for (int m = 0; m < 4; ++m) { const int r = EPI_ROW(u, ai, m);
                const f32x4 p0 = *(const f32x4*)(rsq + (size_t)r * 32 + 8 * fq), p1 = *(const f32x4*)(rsq + (size_t)r * 32 + 8 * fq + 4);
                float s = ((p0[0] + p0[1]) + (p0[2] + p0[3])) + ((p1[0] + p1[1]) + (p1[2] + p1[3]));
                s += __shfl_xor(s, 16); s += __shfl_xor(s, 32);
                const float inv = rsqrtf(s * (1.0f / D) + EPS);
                float h[8];
#pragma unroll
                for (int n = 0; n < 2; ++n)
#pragma unroll
                    for (int j = 0; j < 4; ++j) { const float g = acc[ai][0][m][n][j] * inv, up = acc[ai][1][m][n][j] * inv; h[4 * n + j] = g * fsigmoid(g) * up; }
                u32x4 w; w.x = pk2(h[0], h[1]); w.y = pk2(h[2], h[3]); w.z = pk2(h[4], h[5]); w.w = pk2(h[6], h[7]);
                *(u32x4*)(H + (size_t)r * FF + u.pn * 128 + wc * 32 + 8 * fq) = w; }
    }
};
struct EpiRes2 {
    static constexpr bool AFTER_DRAIN = false;
    float* x;
    __device__ __forceinline__ void operator()(const f32x4 (&acc)[2][2][4][2], const Unit& u, int wr, int wc, int fr, int fq) const {
#pragma unroll
        for (int ai = 0; ai < 2; ++ai)
#pragma unroll
            for (int m = 0; m < 4; ++m) { const int r = EPI_ROW(u, ai, m);
#pragma unroll
                for (int bj = 0; bj < 2; ++bj) { float* p = x + (size_t)r * D + EPI_COL(u, bj);
                    const f32x4 v0 = acc[ai][bj][m][0] + *(const f32x4*)p, v1 = acc[ai][bj][m][1] + *(const f32x4*)(p + 4);
                    *(f32x4*)p = v0; *(f32x4*)(p + 4) = v1; } }
    }
};

__device__ __forceinline__ void panel_exchange(LAS unsigned char* lds, const Unit& u, int wid, int lane, float* xb, unsigned* cnt, unsigned* tmo) {
    LAS float* P = (LAS float*)lds; LAS float* T = (LAS float*)(lds + 4096);
    asm volatile("s_waitcnt lgkmcnt(0)" ::: "memory"); __builtin_amdgcn_s_barrier(); asm volatile("" ::: "memory");
    const int tid = wid * 64 + lane;
    if (tid < 256) {
        const float part = (P[tid * 4 + 0] + P[tid * 4 + 1]) + (P[tid * 4 + 2] + P[tid * 4 + 3]);
        __hip_atomic_store(xb + ((size_t)(u.pm * 256 + tid) * 8 + u.pn), part, __ATOMIC_RELAXED, __HIP_MEMORY_SCOPE_AGENT);
        asm volatile("s_waitcnt vmcnt(0)" ::: "memory");
        if (lane == 0) __hip_atomic_fetch_add(cnt + 16 * u.pm, 1u, __ATOMIC_RELAXED, __HIP_MEMORY_SCOPE_AGENT);
    }
    if (wid == 0) {
        unsigned sp = 0;
        while ((unsigned)__builtin_amdgcn_readfirstlane(__hip_atomic_load(cnt + 16 * u.pm, __ATOMIC_RELAXED, __HIP_MEMORY_SCOPE_AGENT)) < 32u) {
            __builtin_amdgcn_s_sleep(1);
            if ((++sp & 255u) == 0u) { if (__hip_atomic_load(tmo, __ATOMIC_RELAXED, __HIP_MEMORY_SCOPE_AGENT)) break; if (sp > (1u << 18)) { atomicAdd(tmo, 1u); break; } }
        }
        __builtin_amdgcn_fence(__ATOMIC_ACQUIRE, "agent");
    }
    asm volatile("s_waitcnt vmcnt(0) lgkmcnt(0)" ::: "memory"); __builtin_amdgcn_s_barrier(); asm volatile("" ::: "memory");
    if (tid < 256) {
        const float* slot = xb + (size_t)(u.pm * 256 + tid) * 8; float t = 0.f;
#pragma unroll
        for (int k = 0; k < 8; ++k) t += __hip_atomic_load(slot + k, __ATOMIC_RELAXED, __HIP_MEMORY_SCOPE_AGENT);
        T[tid] = t * (1.0f / D) + EPS;
    }
    asm volatile("s_waitcnt lgkmcnt(0)" ::: "memory"); __builtin_amdgcn_s_barrier(); asm volatile("" ::: "memory");
}
#define EPI_SS8(v0, v1) (((v0)[0] * (v0)[0] + (v0)[1] * (v0)[1]) + ((v0)[2] * (v0)[2] + (v0)[3] * (v0)[3]) + ((v1)[0] * (v1)[0] + (v1)[1] * (v1)[1]) + ((v1)[2] * (v1)[2] + (v1)[3] * (v1)[3]))
struct EpiRes1F {
    static constexpr bool AFTER_DRAIN = true;
    const float* x; bf16_t* x1n; float* rms; float* xb; unsigned* cnt; unsigned* tmo;
    __device__ __forceinline__ void fused(f32x4 (&acc)[2][2][4][2], const Unit& u, int wr, int wc, int fr, int fq, LAS unsigned char* lds, int wid, int lane) const {
        LAS float* P = (LAS float*)lds; const LAS float* T = (const LAS float*)(lds + 4096);
#pragma unroll
        for (int ai = 0; ai < 2; ++ai) {
            f32x4 xv[4][2][2];
#pragma unroll
            for (int m = 0; m < 4; ++m)
#pragma unroll
                for (int bj = 0; bj < 2; ++bj) { const float* p = x + (size_t)EPI_ROW(u, ai, m) * D + EPI_COL(u, bj); xv[m][bj][0] = *(const f32x4*)p; xv[m][bj][1] = *(const f32x4*)(p + 4); }
#pragma unroll
            for (int m = 0; m < 4; ++m) { float ss = 0.f;
#pragma unroll
                for (int bj = 0; bj < 2; ++bj) { const f32x4 v0 = acc[ai][bj][m][0] + xv[m][bj][0], v1 = acc[ai][bj][m][1] + xv[m][bj][1];
                    acc[ai][bj][m][0] = v0; acc[ai][bj][m][1] = v1; ss += EPI_SS8(v0, v1); }
                ss += __shfl_xor(ss, 16); ss += __shfl_xor(ss, 32);
                if (fq == 0) P[(ai * 128 + wr * 64 + m * 16 + fr) * 4 + wc] = ss; }
        }
        panel_exchange(lds, u, wid, lane, xb, cnt, tmo);
        const int tid = wid * 64 + lane;
        if (u.pn == 0 && tid < 256) { const float t = T[tid]; rms[u.pm * 256 + tid] = t * rsqrtf(t); }
#pragma unroll
        for (int ai = 0; ai < 2; ++ai)
#pragma unroll
            for (int m = 0; m < 4; ++m) { const int rl = ai * 128 + wr * 64 + m * 16 + fr; const float inv = rsqrtf(T[rl]); const int r = u.pm * 256 + rl;
#pragma unroll
                for (int bj = 0; bj < 2; ++bj) { const f32x4 v0 = acc[ai][bj][m][0] * inv, v1 = acc[ai][bj][m][1] * inv;
                    u32x4 w; w.x = pk2(v0[0], v0[1]); w.y = pk2(v0[2], v0[3]); w.z = pk2(v1[0], v1[1]); w.w = pk2(v1[2], v1[3]);
                    *(u32x4*)(x1n + (size_t)r * D + EPI_COL(u, bj)) = w; } }
    }
};
struct EpiSwigluN {
    static constexpr bool AFTER_DRAIN = false;
    bf16_t* H;
    __device__ __forceinline__ void operator()(const f32x4 (&acc)[2][2][4][2], const Unit& u, int wr, int wc, int fr, int fq) const {
#pragma unroll
        for (int ai = 0; ai < 2; ++ai)
#pragma unroll
            for (int m = 0; m < 4; ++m) { const int r = EPI_ROW(u, ai, m);
                float h[8];
#pragma unroll
                for (int n = 0; n < 2; ++n)
#pragma unroll
                    for (int j = 0; j < 4; ++j) { const float g = acc[ai][0][m][n][j]; h[4 * n + j] = g * fsigmoid(g) * acc[ai][1][m][n][j]; }
                u32x4 w; w.x = pk2(h[0], h[1]); w.y = pk2(h[2], h[3]); w.z = pk2(h[4], h[5]); w.w = pk2(h[6], h[7]);
                *(u32x4*)(H + (size_t)r * FF + u.pn * 128 + wc * 32 + 8 * fq) = w; }
    }
};
struct EpiFinal {
    static constexpr bool AFTER_DRAIN = true;
    const bf16_t* x1n; const float* rms; float* out; const float* gfin; float* xb; unsigned* cnt; unsigned* tmo;
    __device__ __forceinline__ void fused(f32x4 (&acc)[2][2][4][2], const Unit& u, int wr, int wc, int fr, int fq, LAS unsigned char* lds, int wid, int lane) const {
        LAS float* P = (LAS float*)lds; const LAS float* T = (const LAS float*)(lds + 4096);
        u32x4 xw[2][4][2]; float rmv[2][4];
#pragma unroll
        for (int ai = 0; ai < 2; ++ai)
#pragma unroll
            for (int m = 0; m < 4; ++m) { const int r = EPI_ROW(u, ai, m); rmv[ai][m] = rms[r];
#pragma unroll
                for (int bj = 0; bj < 2; ++bj) xw[ai][m][bj] = *(const u32x4*)(x1n + (size_t)r * D + EPI_COL(u, bj)); }
#pragma unroll
        for (int ai = 0; ai < 2; ++ai)
#pragma unroll
            for (int m = 0; m < 4; ++m) { float ss = 0.f; const float rm = rmv[ai][m];
#pragma unroll
                for (int bj = 0; bj < 2; ++bj) { const u32x4 w = xw[ai][m][bj];
                    const f32x4 v0 = acc[ai][bj][m][0] + (f32x4){bflo(w.x), bfhi(w.x), bflo(w.y), bfhi(w.y)} * rm, v1 = acc[ai][bj][m][1] + (f32x4){bflo(w.z), bfhi(w.z), bflo(w.w), bfhi(w.w)} * rm;
                    acc[ai][bj][m][0] = v0; acc[ai][bj][m][1] = v1; ss += EPI_SS8(v0, v1); }
                ss += __shfl_xor(ss, 16); ss += __shfl_xor(ss, 32);
                if (fq == 0) P[(ai * 128 + wr * 64 + m * 16 + fr) * 4 + wc] = ss; }
        f32x4 gg[2][2];
#pragma unroll
        for (int bj = 0; bj < 2; ++bj) { const int c = EPI_COL(u, bj); gg[bj][0] = *(const f32x4*)(gfin + c); gg[bj][1] = *(const f32x4*)(gfin + c + 4); }
        panel_exchange(lds, u, wid, lane, xb, cnt, tmo);
#pragma unroll
        for (int ai = 0; ai < 2; ++ai)
#pragma unroll
            for (int m = 0; m < 4; ++m) { const int rl = ai * 128 + wr * 64 + m * 16 + fr; const float inv = rsqrtf(T[rl]); const int r = u.pm * 256 + rl;
#pragma unroll
                for (int bj = 0; bj < 2; ++bj) { const int c = EPI_COL(u, bj); const f32x4 g0 = gg[bj][0], g1 = gg[bj][1];
                    float* p = out + (size_t)r * D + c;
                    *(f32x4*)p = acc[ai][bj][m][0] * inv * g0; *(f32x4*)(p + 4) = acc[ai][bj][m][1] * inv * g1; } }
    }
};

template <class Epi, bool ALIGN_EPI>
__device__ __forceinline__ void gemm_phase(LAS unsigned char* lds, const Gemm g, const StaticOrder& S, Epi E) {
    const int tid = threadIdx.x, wid = __builtin_amdgcn_readfirstlane(tid >> 6), lane = tid & 63, wr = wid >> 2, wc = wid & 3, fr = lane & 15, fq = lane >> 4;
    const int nt = g.K / BK;
    unsigned voffA[2], voffB[2];
#pragma unroll
    for (int i = 0; i < 2; ++i) { int R, C; stage_rc(tid * 16 + i * 8192, R, C); const int Rb = (R & ~31) + perm32(R & 31);
        voffA[i] = (unsigned)(R * g.lda + C) * 2u; voffB[i] = (unsigned)(Rb * g.ldb + C) * 2u; }
    const size_t kstep = (size_t)(BK * 2);
    const size_t hA = (size_t)HALF * g.lda * 2, hB = (size_t)HALF * g.ldb * 2;
    const size_t tA = 2 * hA, tB = 2 * hB;
    const unsigned ldsw = (unsigned)wid * 1024u;
    const int aoff = lds_byte(wr * 64 + fr, fq * 8), boff = lds_byte(wc * 32 + fr, fq * 8);
#define PG8_SA(b, h) (((b) * 2 + (h)) * HTB)
#define PG8_SB(b, h) ((4 + (b) * 2 + (h)) * HTB)
#define PG8_STAGE(bufoff, gbase, voff) do { _Pragma("unroll") for (int _i = 0; _i < 2; ++_i) \
        __builtin_amdgcn_global_load_lds((const unsigned*)((const char*)(gbase) + (voff)[_i]), (LAS unsigned*)(lds + (bufoff) + ldsw + _i * 8192), 16, 0, 0); } while (0)
#define PG8_LDA(dst, b, h) do { _Pragma("unroll") for (int m = 0; m < 4; ++m) _Pragma("unroll") for (int k = 0; k < 2; ++k) dst[m][k] = *(const LAS bf16x8*)(lds + PG8_SA(b, h) + aoff + m * 2048 + k * 1024); } while (0)
#define PG8_LDB(dst, b, h) do { _Pragma("unroll") for (int n = 0; n < 2; ++n) _Pragma("unroll") for (int k = 0; k < 2; ++k) dst[n][k] = *(const LAS bf16x8*)(lds + PG8_SB(b, h) + boff + n * 2048 + k * 1024); } while (0)
#define PG8_MMA(ai, bj, At, Bt) do { __builtin_amdgcn_s_setprio(1); _Pragma("unroll") for (int m = 0; m < 4; ++m) _Pragma("unroll") for (int n = 0; n < 2; ++n) _Pragma("unroll") for (int k = 0; k < 2; ++k) \
        acc[ai][bj][m][n] = __builtin_amdgcn_mfma_f32_16x16x32_bf16(Bt[n][k], At[m][k], acc[ai][bj][m][n], 0, 0, 0); __builtin_amdgcn_s_setprio(0); } while (0)
#define PG8_WAIT_V(n) asm volatile("s_waitcnt vmcnt(" #n ")" ::: "memory")
#define PG8_WAIT_L(n) asm volatile("s_waitcnt lgkmcnt(" #n ")" ::: "memory")
#define PG8_BAR __builtin_amdgcn_s_barrier()
#define PG8_SCHED __builtin_amdgcn_sched_barrier(0)
    Unit cur, nxt; int ui = 0;
    if (!S.next(0, cur)) return;
    f32x4 acc[2][2][4][2];
#pragma unroll
    for (int a = 0; a < 2; ++a)
#pragma unroll
        for (int b = 0; b < 2; ++b)
#pragma unroll
            for (int m = 0; m < 4; ++m)
#pragma unroll
                for (int n = 0; n < 2; ++n) acc[a][b][m][n] = (f32x4){0.f, 0.f, 0.f, 0.f};
    bf16x8 At[4][2], B0[2][2], B1[2][2];
    const char* cA = (const char*)g.A + (size_t)cur.pm * tA + (size_t)cur.z * g.zoffA; const char* cB = (const char*)g.Bt + (size_t)cur.pn * tB + (size_t)cur.z * g.zoffB;
    PG8_STAGE(PG8_SB(0, 0), cB, voffB); PG8_STAGE(PG8_SB(0, 1), cB + hB, voffB); PG8_STAGE(PG8_SA(0, 0), cA, voffA); PG8_STAGE(PG8_SA(0, 1), cA + hA, voffA);
    if (wr == 1) PG8_BAR;
    PG8_WAIT_V(2); PG8_BAR;
    PG8_STAGE(PG8_SB(1, 0), cB + kstep, voffB); PG8_STAGE(PG8_SA(1, 0), cA + kstep, voffA); PG8_STAGE(PG8_SB(1, 1), cB + hB + kstep, voffB);
    PG8_WAIT_V(6); PG8_BAR;
    for (;;) {
        const bool has_next = S.next(ui + 1, nxt);
        const char* nA = has_next ? (const char*)g.A + (size_t)nxt.pm * tA + (size_t)nxt.z * g.zoffA : cA; const char* nB = has_next ? (const char*)g.Bt + (size_t)nxt.pn * tB + (size_t)nxt.z * g.zoffB : cB;
        for (int t = 0; t < nt; t += 2) {
            const bool last = (t == nt - 2);
            const char* a1 = cA + (size_t)(t + 1) * kstep;
            const char* a2 = last ? nA : cA + (size_t)(t + 2) * kstep; const char* b2 = last ? nB : cB + (size_t)(t + 2) * kstep;
            const char* a3 = a2 + kstep; const char* b3 = b2 + kstep;
            PG8_LDB(B0, 0, 0); PG8_LDB(B1, 0, 1); PG8_SCHED; PG8_LDA(At, 0, 0); PG8_STAGE(PG8_SA(1, 1), a1 + hA, voffA);
            PG8_WAIT_V(8); PG8_WAIT_L(0); PG8_BAR; PG8_MMA(0, 0, At, B0); PG8_MMA(0, 1, At, B1); PG8_BAR; PG8_SCHED;
            PG8_LDA(At, 0, 1); PG8_STAGE(PG8_SB(0, 0), b2, voffB); PG8_STAGE(PG8_SB(0, 1), b2 + hB, voffB); PG8_STAGE(PG8_SA(0, 0), a2, voffA);
            PG8_WAIT_V(8); PG8_WAIT_L(0); PG8_BAR; PG8_MMA(1, 0, At, B0); PG8_MMA(1, 1, At, B1); PG8_BAR; PG8_SCHED;
            PG8_LDB(B0, 1, 0); PG8_LDB(B1, 1, 1); PG8_SCHED; PG8_LDA(At, 1, 0); PG8_STAGE(PG8_SA(0, 1), a2 + hA, voffA);
            PG8_WAIT_V(8); PG8_WAIT_L(0); PG8_BAR; PG8_MMA(0, 0, At, B0); PG8_MMA(0, 1, At, B1); PG8_BAR; PG8_SCHED;
            PG8_LDA(At, 1, 1); PG8_STAGE(PG8_SB(1, 0), b3, voffB); PG8_STAGE(PG8_SB(1, 1), b3 + hB, voffB); PG8_STAGE(PG8_SA(1, 0), a3, voffA);
            PG8_WAIT_V(8); PG8_WAIT_L(0); PG8_BAR; PG8_MMA(1, 0, At, B0); PG8_MMA(1, 1, At, B1); PG8_BAR; PG8_SCHED;
        }
        if constexpr (ALIGN_EPI) { if (wr == 0) PG8_BAR; }
        if constexpr (!Epi::AFTER_DRAIN) E(acc, cur, wr, wc, fr, fq);
        if (!has_next) break;
#pragma unroll
        for (int a = 0; a < 2; ++a)
#pragma unroll
            for (int b = 0; b < 2; ++b)
#pragma unroll
                for (int m = 0; m < 4; ++m)
#pragma unroll
                    for (int n = 0; n < 2; ++n) acc[a][b][m][n] = (f32x4){0.f, 0.f, 0.f, 0.f};
        cur = nxt; cA = nA; cB = nB; ++ui;
        if constexpr (ALIGN_EPI) { if (wr == 1) PG8_BAR; }
    }
    PG8_WAIT_V(0);
    if constexpr (!ALIGN_EPI) { if (wr == 0) PG8_BAR; }
    PG8_BAR;
    if constexpr (Epi::AFTER_DRAIN) E.fused(acc, cur, wr, wc, fr, fq, lds, wid, lane);
#undef PG8_SA
#undef PG8_SB
#undef PG8_STAGE
#undef PG8_LDA
#undef PG8_LDB
#undef PG8_MMA
#undef PG8_WAIT_V
#undef PG8_WAIT_L
#undef PG8_BAR
#undef PG8_SCHED
}
}

#define MFMA32(a, b, c) __builtin_amdgcn_mfma_f32_32x32x16_bf16((a), (b), (c), 0, 0, 0)
constexpr float SB_EXIT = -150.0f;
constexpr int WIN_KEYS = 448;
constexpr int KW_PITCH = 144;
constexpr int VW_PITCH = WIN_KEYS * 2 + 8;
constexpr int VW_OFF = WIN_KEYS * KW_PITCH;
constexpr int ATT_FLAG_OFF = VW_OFF + 64 * VW_PITCH;
static_assert(ATT_FLAG_OFF + 16 <= 131072 && VW_OFF % 16 == 0, "attention LDS map");

struct WinRegs { bf16x8 kv[7]; bf16x8 vv[8]; };
__device__ __forceinline__ void win_issue(WinRegs& w, const bf16_t* Kp, const bf16_t* Vp, int W0, int nk, int tid) {
    const bf16x8* ksrc = (const bf16x8*)(Kp + (size_t)W0 * 64);
#pragma unroll
    for (int i = 0; i < 7; ++i) { const int idx = tid + 512 * i; w.kv[i] = ksrc[idx < nk * 8 ? idx : 0]; }
    const int kk = tid & 31, hh = (tid >> 5) & 1, wv = tid >> 6;
#pragma unroll
    for (int ps = 0; ps < 2; ++ps) { const int key = 32 * (wv + 8 * ps) + kk; const bf16_t* vp = Vp + (size_t)(W0 + (key < nk ? key : 0)) * 64 + 8 * hh;
#pragma unroll
        for (int c2 = 0; c2 < 4; ++c2) w.vv[ps * 4 + c2] = *(const bf16x8*)(vp + 16 * c2); }
}
__device__ __forceinline__ void win_commit(LAS unsigned char* lds, const WinRegs& w, int nk, int tid) {
#pragma unroll
    for (int i = 0; i < 7; ++i) { const int idx = tid + 512 * i; if (idx < nk * 8) *(LAS bf16x8*)(lds + (idx >> 3) * KW_PITCH + 16 * (idx & 7)) = w.kv[i]; }
    const int kk = tid & 31, hh = (tid >> 5) & 1, wv = tid >> 6;
#pragma unroll
    for (int ps = 0; ps < 2; ++ps) { const int key = 32 * (wv + 8 * ps) + kk;
        if (key < nk) {
#pragma unroll
            for (int c2 = 0; c2 < 4; ++c2)
#pragma unroll
                for (int j = 0; j < 8; ++j) *(LAS bf16_t*)(lds + VW_OFF + (8 * (2 * c2 + hh) + j) * VW_PITCH + 2 * key) = (bf16_t)w.vv[ps * 4 + c2][j];
        } }
}
__device__ __forceinline__ f32x16 qk_tile(const LAS unsigned char* lds, int kr0, const bf16x8 (&Bq)[4], int q, int hi) {
    f32x16 S;
#pragma unroll
    for (int i = 0; i < 16; ++i) S[i] = 0.f;
    const LAS unsigned char* kp = lds + (kr0 + q) * KW_PITCH + 16 * hi;
#pragma unroll
    for (int kk = 0; kk < 4; ++kk) S = MFMA32(*(const LAS bf16x8*)(kp + 32 * kk), Bq[kk], S);
    return S;
}
__device__ __forceinline__ void pv_acc(const LAS unsigned char* lds, int kr0, const bf16x8 (&P)[2], f32x16& O0, f32x16& O1, int q, int hi) {
#pragma unroll
    for (int c = 0; c < 2; ++c) {
        const LAS unsigned char* p0 = lds + VW_OFF + q * VW_PITCH + (kr0 + 16 * c + 4 * hi) * 2;
        const LAS unsigned char* p1 = p0 + 32 * VW_PITCH;
        const s16x4 a0 = *(const LAS s16x4*)p0, a1 = *(const LAS s16x4*)(p0 + 16);
        const s16x4 b0 = *(const LAS s16x4*)p1, b1 = *(const LAS s16x4*)(p1 + 16);
        const bf16x8 A0 = {a0[0], a0[1], a0[2], a0[3], a1[0], a1[1], a1[2], a1[3]};
        const bf16x8 A1 = {b0[0], b0[1], b0[2], b0[3], b1[0], b1[1], b1[2], b1[3]};
        O0 = MFMA32(A0, P[c], O0); O1 = MFMA32(A1, P[c], O1);
    }
}
__device__ __forceinline__ void pack_p(const float (&a)[16], bf16x8 (&P)[2]) {
#pragma unroll
    for (int c = 0; c < 2; ++c) { u32x4 w; w.x = pk2(a[8 * c], a[8 * c + 1]); w.y = pk2(a[8 * c + 2], a[8 * c + 3]); w.z = pk2(a[8 * c + 4], a[8 * c + 5]); w.w = pk2(a[8 * c + 6], a[8 * c + 7]);
        P[c] = __builtin_bit_cast(bf16x8, w); }
}
typedef unsigned u32x2s __attribute__((ext_vector_type(2)));
__device__ __forceinline__ void store_o_half(bf16_t* p  , const f32x16& O, float sc, int hi) {
#pragma unroll
    for (int pr = 0; pr < 2; ++pr) { const int ge = 2 * pr, go = 2 * pr + 1;
        const unsigned ex = pk2(O[4 * ge] * sc, O[4 * ge + 1] * sc), ey = pk2(O[4 * ge + 2] * sc, O[4 * ge + 3] * sc);
        const unsigned ox = pk2(O[4 * go] * sc, O[4 * go + 1] * sc), oy = pk2(O[4 * go + 2] * sc, O[4 * go + 3] * sc);
        const u32x2s sx = __builtin_amdgcn_permlane32_swap(ex, ox, false, false), sy = __builtin_amdgcn_permlane32_swap(ey, oy, false, false);
        u32x4 v; v.x = sx.x; v.y = sy.x; v.z = sx.y; v.w = sy.y;
        *(u32x4*)(p + 8 * (2 * pr + hi)) = v; }
}
__device__ __forceinline__ void store_o(bf16_t* orow  , const f32x16& O0, const f32x16& O1, float sc, int hi) {
    store_o_half(orow, O0, sc, hi); store_o_half(orow + 32, O1, sc, hi);
}

template <bool DIAG>
__device__ __forceinline__ void sb_tile(const f32x16& S, int q, int hi, float& carry, float& cl, bf16x8 (&P)[2]) {
    float bt[16], fl[16], a[16];
#pragma unroll
    for (int i = 0; i < 16; ++i) {
        const float y = S[i];
        const float e = __builtin_amdgcn_exp2f(-fabsf(y)), r = __builtin_amdgcn_rcpf(1.f + e), er = e * r;
        const bool pos = y >= 0.f;
        bt[i] = pos ? r : er; fl[i] = pos ? er : r;
        if (DIAG) { const int key = 8 * (i >> 2) + 4 * hi + (i & 3); if (!(key < q)) { bt[i] = 0.f; fl[i] = 1.f; } }
    }
    float g[4], pg[4];
#pragma unroll
    for (int gi = 0; gi < 4; ++gi) { g[gi] = (fl[4 * gi] * fl[4 * gi + 1]) * (fl[4 * gi + 2] * fl[4 * gi + 3]); pg[gi] = __shfl_xor(g[gi], 32); }
    float above = cl, tp = 1.f;
#pragma unroll
    for (int gi = 3; gi >= 0; --gi) {
        const float s3 = above * (hi == 0 ? pg[gi] : 1.f);
        const float s2 = s3 * fl[4 * gi + 3], s1 = s2 * fl[4 * gi + 2], s0 = s1 * fl[4 * gi + 1];
        a[4 * gi + 3] = bt[4 * gi + 3] * s3; a[4 * gi + 2] = bt[4 * gi + 2] * s2; a[4 * gi + 1] = bt[4 * gi + 1] * s1; a[4 * gi + 0] = bt[4 * gi + 0] * s0;
        const float gp = g[gi] * pg[gi];
        above *= gp; tp *= gp;
    }
    cl = above;
    carry += __builtin_amdgcn_logf(tp);
    pack_p(a, P);
}

struct MUnit { int kind, h, QT, reuse; };
__device__ __forceinline__ int munit_w0(const MUnit& u) { const int back = u.kind == 0 ? 192 : 128; const int w = u.QT * 256 - back; return w < 0 ? 0 : w; }
__device__ __forceinline__ const bf16_t* munit_kplane(const bf16_t* QKV, const MUnit& u) { return QKV + (size_t)(u.kind == 0 ? KB_OFF / 64 + u.h : KA_OFF / 64 + (u.h >> 2)) * M * 64; }
__device__ __forceinline__ const bf16_t* munit_vplane(const bf16_t* QKV, const MUnit& u) { return QKV + (size_t)(u.kind == 0 ? VB_OFF / 64 + u.h : VA_OFF / 64 + (u.h >> 2)) * M * 64; }
__device__ __forceinline__ void munit_issue(WinRegs& w, bf16x8 (&Bq)[4], const bf16_t* QKV, const MUnit& u, int wave, int lane) {
    const int W0 = munit_w0(u);
    if (!u.reuse) win_issue(w, munit_kplane(QKV, u), munit_vplane(QKV, u), W0, u.QT * 256 + 256 - W0, wave * 64 + lane);
    const bf16_t* qp = QKV + ((size_t)((u.kind == 0 ? QB_OFF : QA_OFF) / 64 + u.h) * M + u.QT * 256 + 32 * wave + (lane & 31)) * 64 + 8 * (lane >> 5);
#pragma unroll
    for (int kk = 0; kk < 4; ++kk) Bq[kk] = *(const bf16x8*)(qp + 16 * kk);
}

__device__ __forceinline__ void attn_b_compute(LAS unsigned char* lds, const bf16_t* QKV, bf16_t* ATT, const bf16x8 (&Bq)[4], int h, int QT, int wave, int lane) {
    const int q = lane & 31, hi = lane >> 5, T0 = QT * 256, t0 = T0 + 32 * wave;
    f32x16 O0, O1;
#pragma unroll
    for (int i = 0; i < 16; ++i) { O0[i] = 0.f; O1[i] = 0.f; }
    float carry = 0.f, cl = 1.f; bool done = false; int s0 = t0;
    volatile LAS unsigned* flag = (volatile LAS unsigned*)(lds + ATT_FLAG_OFF);
    int Whi = T0 + 256, W0 = T0 - 192 < 0 ? 0 : T0 - 192;
    for (;;) {
        while (!done && s0 >= W0) {
            const f32x16 S = qk_tile(lds, s0 - W0, Bq, q, hi);
            bf16x8 P[2];
            if (s0 == t0) sb_tile<true>(S, q, hi, carry, cl, P); else sb_tile<false>(S, q, hi, carry, cl, P);
            pv_acc(lds, s0 - W0, P, O0, O1, q, hi);
            if (__all(carry < SB_EXIT)) done = true;
            s0 -= 32;
        }
        if (s0 < 0) done = true;
        if (!done && lane == 0) flag[0] = 1u;
        __syncthreads();
        const bool any = flag[0] != 0u;
        if (!any || W0 == 0) break;
        __syncthreads();
        Whi = W0; W0 = W0 - WIN_KEYS < 0 ? 0 : W0 - WIN_KEYS;
        if (threadIdx.x == 0) flag[0] = 0u;
        { WinRegs w; win_issue(w, QKV + (size_t)(KB_OFF / 64 + h) * M * 64, QKV + (size_t)(VB_OFF / 64 + h) * M * 64, W0, Whi - W0, wave * 64 + lane); win_commit(lds, w, Whi - W0, wave * 64 + lane); }
        __syncthreads();
    }
    store_o(ATT + (size_t)(t0 + q) * D + 1024 + h * 64, O0, O1, 1.f, hi);
}

__device__ __forceinline__ void attn_a_compute(LAS unsigned char* lds, bf16_t* ATT, const bf16x8 (&Bq)[4], int h, int QT, int wave, int lane, float sink2, float slope2) {
    const int q = lane & 31, hi = lane >> 5, T0 = QT * 256, t0 = T0 + 32 * wave;
    f32x16 O0, O1;
#pragma unroll
    for (int i = 0; i < 16; ++i) { O0[i] = 0.f; O1[i] = 0.f; }
    float mrun = sink2, lrun = 1.f;
    const int W0 = T0 - 128 < 0 ? 0 : T0 - 128;
    for (int s0 = (t0 - 128 < 0 ? 0 : t0 - 128); s0 <= t0; s0 += 32) {
        const f32x16 S = qk_tile(lds, s0 - W0, Bq, q, hi);
        const int dq = t0 - s0 + q;
        float s[16]; float mx = -INFINITY;
#pragma unroll
        for (int i = 0; i < 16; ++i) { const int dist = dq - (8 * (i >> 2) + 4 * hi + (i & 3));
            s[i] = ((unsigned)dist < 128u) ? S[i] - slope2 * (float)dist : -INFINITY; mx = fmaxf(mx, s[i]); }
        mx = fmaxf(mx, __shfl_xor(mx, 32));
        const float mnew = fmaxf(mrun, mx), alpha = __builtin_amdgcn_exp2f(mrun - mnew);
        float a[16]; float rs = 0.f;
#pragma unroll
        for (int i = 0; i < 16; ++i) { a[i] = __builtin_amdgcn_exp2f(s[i] - mnew); rs += a[i]; }
        rs += __shfl_xor(rs, 32);
        lrun = lrun * alpha + rs; mrun = mnew;
#pragma unroll
        for (int i = 0; i < 16; ++i) { O0[i] *= alpha; O1[i] *= alpha; }
        bf16x8 P[2];
        pack_p(a, P);
        pv_acc(lds, s0 - W0, P, O0, O1, q, hi);
    }
    __syncthreads();
    store_o(ATT + (size_t)(t0 + q) * D + h * 64, O0, O1, 1.f / lrun, hi);
}

__device__ __forceinline__ bool munit_get(int j, int G, MUnit& u) {
    const int b = (int)blockIdx.x, nper = b < 512 ? (512 - b + G - 1) / G : 0;
    if (j >= 2 * nper) return false;
    const int kind = j >= nper ? 1 : 0, uu = b + (j - kind * nper) * G;
    u.kind = kind; u.h = uu >> 5; u.QT = uu & 31; u.reuse = 0;
    if (kind == 1 && G == 256) { const int jj = j - nper; u.h = 2 * (b >> 5) + jj; u.QT = b & 31; u.reuse = jj; }
    return true;
}
__device__ __forceinline__ void mixer_phase(LAS unsigned char* lds, const bf16_t* QKV, bf16_t* ATT, const float* sinks, int G, int wave, int lane) {
    MUnit cur, nxt;
    if (!munit_get(0, G, cur)) return;
    WinRegs w; bf16x8 Bqn[4];
    munit_issue(w, Bqn, QKV, cur, wave, lane);
    for (int j = 0;; ++j) {
        bf16x8 Bq[4];
#pragma unroll
        for (int kk = 0; kk < 4; ++kk) Bq[kk] = Bqn[kk];
        if (!cur.reuse) {
            win_commit(lds, w, cur.QT * 256 + 256 - munit_w0(cur), wave * 64 + lane);
            if (threadIdx.x == 0) *(volatile LAS unsigned*)(lds + ATT_FLAG_OFF) = 0u;
            __syncthreads();
        }
        const bool has_next = munit_get(j + 1, G, nxt);
        if (has_next) munit_issue(w, Bqn, QKV, nxt, wave, lane);
        if (cur.kind == 0) attn_b_compute(lds, QKV, ATT, Bq, cur.h, cur.QT, wave, lane);
        else attn_a_compute(lds, ATT, Bq, cur.h, cur.QT, wave, lane, sinks[cur.h] * LOG2E, __builtin_amdgcn_exp2f(-0.5f * (float)(cur.h + 1)) * LOG2E);
        if (!has_next) break;
        cur = nxt;
    }
}

__device__ __forceinline__ float wave_sum(float v) {
#pragma unroll
    for (int o = 1; o < 64; o <<= 1) v += __shfl_xor(v, o);
    return v;
}
struct TItem { const float* src; bf16_t* dst; const float* ks; int N, ldT; float cs; };
__device__ __forceinline__ TItem p0_decode(int it, int lane, const float* w_in, const float* w_a, const float* w_b, const float* w_out, const float* w_ffn, const float* w_dn, const float* g_ffn,
                                           bf16_t* Win_t, bf16_t* Wab_t, bf16_t* Wout_t, bf16_t* Wffn_t, bf16_t* Wdn_t) {
    constexpr int I_IN = (D / 64) * (INW / 32), I_AB = (1024 / 64) * (D / 32), I_OUT = (D / 64) * (D / 32), I_FFN = (D / 64) * (FF2 / 32);
    const int g = lane & 7, nq = lane >> 3;
    const float* W; bf16_t* WT; int N, ldT, nb, orow_adj = 0; float cs = 1.f; const float* ks = nullptr; int r = it; int mode = 0;
    if (r < I_IN) { W = w_in; WT = Win_t; N = INW; ldT = D; mode = 1; }
    else if ((r -= I_IN) < I_AB) { W = w_a; WT = Wab_t; N = D; ldT = 1024; }
    else if ((r -= I_AB) < I_AB) { W = w_b; WT = Wab_t + (size_t)D * 1024; N = D; ldT = 1024; }
    else if ((r -= I_AB) < I_OUT) { W = w_out; WT = Wout_t; N = D; ldT = D; }
    else if ((r -= I_OUT) < I_FFN) { W = w_ffn; WT = Wffn_t; N = FF2; ldT = D; mode = 2; ks = g_ffn; }
    else { r -= I_FFN; W = w_dn; WT = Wdn_t; N = D; ldT = FF; }
    nb = N / 32; const int kb = r / nb, n0 = (r - kb * nb) * 32, k0 = kb * 64;
    int orow = n0;
    if (mode == 1) cs = (n0 < 1024 || (n0 >= QB_OFF && n0 < KB_OFF)) ? QSCALE : 1.f;
    if (mode == 2) { const int up = n0 >= FF, nn = up ? n0 - FF : n0; orow = (nn >> 7) * 256 + up * 128 + (nn & 127); }
    (void)orow_adj;
    TItem t; t.src = W + (size_t)(k0 + 8 * g) * N + n0 + 4 * nq; t.dst = WT + (size_t)(orow + 4 * nq) * ldT + k0 + 8 * g; t.ks = ks ? ks + k0 + 8 * g : nullptr; t.N = N; t.ldT = ldT; t.cs = cs;
    return t;
}
__device__ __forceinline__ void p0_load(const TItem& t, f32x4 (&v)[8]) {
#pragma unroll
    for (int kk = 0; kk < 8; ++kk) v[kk] = __builtin_nontemporal_load((const f32x4*)(t.src + (size_t)kk * t.N));
}
__device__ __forceinline__ void p0_store(const TItem& t, const f32x4 (&v)[8]) {
    float sc[8];
    if (t.ks) { const f32x4 a = *(const f32x4*)t.ks, b = *(const f32x4*)(t.ks + 4); sc[0] = a[0]; sc[1] = a[1]; sc[2] = a[2]; sc[3] = a[3]; sc[4] = b[0]; sc[5] = b[1]; sc[6] = b[2]; sc[7] = b[3]; }
    else {
#pragma unroll
        for (int kk = 0; kk < 8; ++kk) sc[kk] = 1.f; }
#pragma unroll
    for (int kk = 0; kk < 8; ++kk) sc[kk] *= t.cs;
#pragma unroll
    for (int j = 0; j < 4; ++j) { u32x4 o; o.x = pk2(v[0][j] * sc[0], v[1][j] * sc[1]); o.y = pk2(v[2][j] * sc[2], v[3][j] * sc[3]); o.z = pk2(v[4][j] * sc[4], v[5][j] * sc[5]); o.w = pk2(v[6][j] * sc[6], v[7][j] * sc[7]);
        *(u32x4*)(t.dst + (size_t)j * t.ldT) = o; }
}
__device__ __forceinline__ void norm_row_load(const float* x, int m, int lane, f32x4 (&v)[8]) {
    const f32x4* xr = (const f32x4*)(x + (size_t)m * D) + lane;
#pragma unroll
    for (int j = 0; j < 8; ++j) v[j] = __builtin_nontemporal_load(xr + 64 * j);
}
__device__ __forceinline__ float norm_row_inv(const f32x4 (&v)[8]) {
    float s = 0.f;
#pragma unroll
    for (int j = 0; j < 8; ++j) s += (v[j][0] * v[j][0] + v[j][1] * v[j][1]) + (v[j][2] * v[j][2] + v[j][3] * v[j][3]);
    return rsqrtf(wave_sum(s) * (1.f / D) + EPS);
}

#define XB_TMO      128
#define XB_XCNT(j)  (256  + 64 * (j))
#define XB_XSUB(j)  (1280 + 64 * (j))
#define XB_XGEN(j)  (2304 + 64 * (j))
#define XB_TOP      3328
#define XB_TOPGEN   3392
#define XCD_BAR_WORDS 3456
#define XB_SPIN_CAP (1u << 18)
__device__ __forceinline__ unsigned xb_ld(unsigned* p)              { return __hip_atomic_load(p, __ATOMIC_RELAXED, __HIP_MEMORY_SCOPE_AGENT); }
__device__ __forceinline__ unsigned xb_add(unsigned* p, unsigned v) { return __hip_atomic_fetch_add(p, v, __ATOMIC_RELAXED, __HIP_MEMORY_SCOPE_AGENT); }
__device__ __forceinline__ unsigned xb_xcc_id() { return (unsigned)__builtin_amdgcn_s_getreg((3 << 11) | 20) & 0xFu; }
#define XB_SPIN(cond, bar) do { unsigned _sp = 0; while (cond) { __builtin_amdgcn_s_sleep(1); \
    if ((++_sp & 255u) == 0u) { if (xb_ld(&(bar)[XB_TMO])) break; if (_sp > XB_SPIN_CAP) { atomicAdd(&(bar)[XB_TMO], 1u); break; } } } } while (0)
struct XcdBarrier { unsigned* bar; unsigned x; volatile LAS unsigned* st; };
__device__ __forceinline__ XcdBarrier xcd_barrier_post(unsigned* bar, volatile LAS unsigned* st) {
    XcdBarrier b; b.bar = bar; b.x = xb_xcc_id(); b.st = st;
    if (threadIdx.x == 0) (void)xb_add(&bar[XB_XCNT(b.x)], 1u);
    return b;
}
__device__ __forceinline__ void xcd_barrier_complete(unsigned* bar, unsigned x, unsigned& nloc, unsigned& nx) {
    const unsigned G = gridDim.x * gridDim.y * gridDim.z;
    unsigned sum, cnt, mine, sp = 0u;
    for (;;) {
        sum = 0u; cnt = 0u; mine = 0u;
#pragma unroll
        for (unsigned j = 0; j < 16; ++j) { const unsigned c = xb_ld(&bar[XB_XCNT(j)]); sum += c; cnt += (c > 0u) ? 1u : 0u; mine = (j == x) ? c : mine; }
        if (sum == G) break;
        __builtin_amdgcn_s_sleep(1);
        if ((++sp & 255u) == 0u) { if (xb_ld(&bar[XB_TMO])) break; if (sp > XB_SPIN_CAP) { atomicAdd(&bar[XB_TMO], 1u); break; } }
    }
    nloc = mine > 0u ? mine : 1u; nx = cnt > 0u ? cnt : 1u;
}
__device__ __forceinline__ void xcd_barrier(const XcdBarrier& b) {
    asm volatile("s_waitcnt vmcnt(0)" ::: "memory");
    __syncthreads();
    if (threadIdx.x == 0) {
        unsigned* bar = b.bar;
        __builtin_amdgcn_s_waitcnt(0);
        unsigned nloc = b.st[0], nx = b.st[1];
        if (nloc == 0u) { xcd_barrier_complete(bar, b.x, nloc, nx); b.st[0] = nloc; b.st[1] = nx; }
        const unsigned old = xb_add(&bar[XB_XSUB(b.x)], 1u);
        const unsigned gen = old / nloc;
        if (old + 1u == (gen + 1u) * nloc) {
            __builtin_amdgcn_fence(__ATOMIC_RELEASE, "agent");
            asm volatile("s_waitcnt vmcnt(0)" ::: "memory");
            const unsigned og = xb_add(&bar[XB_TOP], 1u);
            const unsigned tg = og / nx;
            if (og + 1u == (tg + 1u) * nx) xb_add(&bar[XB_TOPGEN], 1u);
            else XB_SPIN(xb_ld(&bar[XB_TOPGEN]) == tg, bar);
            __builtin_amdgcn_fence(__ATOMIC_ACQUIRE, "agent");
            xb_add(&bar[XB_XGEN(b.x)], 1u);
            asm volatile("s_waitcnt vmcnt(0)" ::: "memory");
        } else {
            XB_SPIN(xb_ld(&bar[XB_XGEN(b.x)]) == gen, bar);
            __builtin_amdgcn_fence(__ATOMIC_ACQUIRE, "agent");
            asm volatile("s_waitcnt vmcnt(0)" ::: "memory");
        }
    }
    __syncthreads();
}

constexpr int I_IN = (D / 64) * (INW / 32), I_AB = (1024 / 64) * (D / 32), I_OUT = (D / 64) * (D / 32), I_FFN = (D / 64) * (FF2 / 32), I_DN = (FF / 64) * (D / 32);
constexpr int IT_P1_LO = I_IN, IT_P1_HI = I_IN + 2 * I_AB + I_OUT + I_FFN, IT_END = IT_P1_HI + I_DN;
#define CONVERT_ITEMS(lo_, hi_, widx_, nw_) do { \
    for (int it = (lo_) + (widx_); it < (hi_); it += 4 * (nw_)) { \
        const bool hasb = it + (nw_) < (hi_), hasc = it + 2 * (nw_) < (hi_), hasd = it + 3 * (nw_) < (hi_); \
        const TItem ta = p0_decode(it, lane, w_in, w_a, w_b, w_out, w_ffn, w_dn, g_ffn, Win_t, Wab_t, Wout_t, Wffn_t, Wdn_t); \
        const TItem tb = p0_decode(hasb ? it + (nw_) : it, lane, w_in, w_a, w_b, w_out, w_ffn, w_dn, g_ffn, Win_t, Wab_t, Wout_t, Wffn_t, Wdn_t); \
        const TItem tc = p0_decode(hasc ? it + 2 * (nw_) : it, lane, w_in, w_a, w_b, w_out, w_ffn, w_dn, g_ffn, Win_t, Wab_t, Wout_t, Wffn_t, Wdn_t); \
        const TItem td = p0_decode(hasd ? it + 3 * (nw_) : it, lane, w_in, w_a, w_b, w_out, w_ffn, w_dn, g_ffn, Win_t, Wab_t, Wout_t, Wffn_t, Wdn_t); \
        f32x4 va[8], vb[8], vc[8], vd[8]; \
        p0_load(ta, va); p0_load(tb, vb); p0_load(tc, vc); p0_load(td, vd); \
        p0_store(ta, va); if (hasb) p0_store(tb, vb); if (hasc) p0_store(tc, vc); if (hasd) p0_store(td, vd); \
    } } while (0)

struct Args { const float* in[11]; float* out; unsigned char* ws; int ph_lo, ph_hi; };

__global__ void __launch_bounds__(512, 2) fwd_megakernel(Args args) {
    extern __shared__ __attribute__((aligned(16))) unsigned char lds_raw[];
    LAS unsigned char* lds = (LAS unsigned char*)lds_raw;
    cg::grid_group grid = cg::this_grid();
    const int tid = threadIdx.x, lane = tid & 63, wave = __builtin_amdgcn_readfirstlane(tid >> 6);
    const int G = gridDim.x, gw = blockIdx.x * 8 + wave, NGW = G * 8;
    const int lo = args.ph_lo, hi = args.ph_hi;
    const bool fusedfin = (G == 256) && (MK_N_LAUNCHES == 1);
    unsigned char* ws = args.ws;
    const float* x = args.in[0]; const float* g_mix = args.in[1]; const float* w_in = args.in[2]; const float* sinks = args.in[3];
    const float* w_a = args.in[4]; const float* w_b = args.in[5]; const float* w_out = args.in[6]; const float* g_ffn = args.in[7];
    const float* w_ffn = args.in[8]; const float* w_dn = args.in[9]; const float* g_fin = args.in[10];
    float* out = args.out;
    bf16_t* Win_t = (bf16_t*)(ws + WS_WIN); bf16_t* Wab_t = (bf16_t*)(ws + WS_WAB); bf16_t* Wout_t = (bf16_t*)(ws + WS_WOUT);
    bf16_t* Wffn_t = (bf16_t*)(ws + WS_WFFN); bf16_t* Wdn_t = (bf16_t*)(ws + WS_WDN);
    bf16_t* XN = (bf16_t*)(ws + WS_XN); bf16_t* MRG = XN; bf16_t* ATT = (bf16_t*)(ws + WS_ATT); bf16_t* X1B = ATT;
    bf16_t* QKV = (bf16_t*)(ws + WS_PROJ); bf16_t* GB = (bf16_t*)(ws + WS_PROJ + 72 * MiB); bf16_t* H = QKV; float* RSQ = (float*)(ws + WS_RSQ);
#define IN(k) (lo <= (k) && (k) < hi)
#ifdef PROBE_PH
#define PH_BEGIN(k) if (IN(k)) for (int rep_ = 0; rep_ < ((k) == PROBE_PH ? 2 : 1); ++rep_, ((k) == PROBE_PH && rep_ == 1) ? xcd_barrier(bar) : (void)0)
#else
#define PH_BEGIN(k) if (IN(k))
#endif
#define SEAM(k) do { if (IN(k) && IN((k) + 1)) xcd_barrier(bar); } while (0)
    if (args.ph_lo < 0) grid.sync();
    if (tid < 8) ((LAS unsigned*)(lds + 131072))[tid] = 0u;
    __syncthreads();
    const XcdBarrier bar = xcd_barrier_post((unsigned*)(ws + WS_CTL), (volatile LAS unsigned*)(lds + 131072));

    PH_BEGIN(0) {
        CONVERT_ITEMS(0, I_IN, gw, NGW);
        f32x4 gmix[8];
#pragma unroll
        for (int j = 0; j < 8; ++j) gmix[j] = ((const f32x4*)g_mix + lane)[64 * j];
        for (int m = gw; m < M; m += 2 * NGW) {
            const int m2 = m + NGW;
            const bool has2 = m2 < M;
            f32x4 va[8], vb[8];
            norm_row_load(x, m, lane, va); norm_row_load(x, has2 ? m2 : m, lane, vb);
            const float ia = norm_row_inv(va), ib = norm_row_inv(vb);
            u32x2* oa = (u32x2*)(XN + (size_t)m * D) + lane; u32x2* ob = (u32x2*)(XN + (size_t)m2 * D) + lane;
#pragma unroll
            for (int j = 0; j < 8; ++j) { const f32x4 gg = gmix[j];
                u32x2 w; w.x = pk2(va[j][0] * ia * gg[0], va[j][1] * ia * gg[1]); w.y = pk2(va[j][2] * ia * gg[2], va[j][3] * ia * gg[3]); oa[64 * j] = w;
                if (has2) { u32x2 w2; w2.x = pk2(vb[j][0] * ib * gg[0], vb[j][1] * ib * gg[1]); w2.y = pk2(vb[j][2] * ib * gg[2], vb[j][3] * ib * gg[3]); ob[64 * j] = w2; } }
        }
    }
    SEAM(0);
    PH_BEGIN(1) {
        pg8::Gemm g{XN, Win_t, D, D, D, 0, 0}; pg8::StaticOrder S; S.init(M, INW, G, (int)blockIdx.x, 1);
        pg8::EpiProj E{QKV, GB};
        pg8::gemm_phase<pg8::EpiProj, true>(lds, g, S, E);
        { const int rem = S.nwg % G; if (rem && (int)blockIdx.x >= rem) CONVERT_ITEMS(IT_P1_LO, IT_P1_HI, ((int)blockIdx.x - rem) * 8 + wave, (G - rem) * 8);
          else if (!rem) CONVERT_ITEMS(IT_P1_LO, IT_P1_HI, gw, NGW); }
    }
    SEAM(1);
    PH_BEGIN(2) {
        mixer_phase(lds, QKV, ATT, sinks, G, wave, lane);
    }
    SEAM(2);
    PH_BEGIN(3) {
        pg8::Gemm g{ATT, Wab_t, D, 1024, 1024, (size_t)1024 * 2, (size_t)D * 1024 * 2}; pg8::StaticOrder S; S.init(M, D, G, (int)blockIdx.x, 2);
        pg8::EpiBranch E{GB, out, MRG};
        pg8::gemm_phase<pg8::EpiBranch, true>(lds, g, S, E);
    }
    SEAM(3);
    PH_BEGIN(4) {
        pg8::Gemm g{MRG, Wout_t, D, D, D, 0, 0}; pg8::StaticOrder S; S.init(M, D, G, (int)blockIdx.x, 1);
        if (fusedfin) { pg8::EpiRes1F E{x, X1B, RSQ, (float*)(ws + WS_CTL + 65536 + 262144), (unsigned*)(ws + WS_CTL + 16384), (unsigned*)(ws + WS_CTL) + XB_TMO};
            pg8::gemm_phase<pg8::EpiRes1F, false>(lds, g, S, E); }
        else { pg8::EpiRes1 E{x, out, X1B, RSQ, true};
            pg8::gemm_phase<pg8::EpiRes1, false>(lds, g, S, E); }
    }
    SEAM(4);
    PH_BEGIN(5) {
        pg8::Gemm g{X1B, Wffn_t, D, D, D, 0, 0}; pg8::StaticOrder S; S.init(M, FF2, G, (int)blockIdx.x, 1);
        if (fusedfin) { pg8::EpiSwigluN E{H};
            pg8::gemm_phase<pg8::EpiSwigluN, true>(lds, g, S, E); }
        else { pg8::EpiSwiglu E{RSQ, H};
            pg8::gemm_phase<pg8::EpiSwiglu, true>(lds, g, S, E); }
        { const int rem = S.nwg % G; if (rem && (int)blockIdx.x >= rem) CONVERT_ITEMS(IT_P1_HI, IT_END, ((int)blockIdx.x - rem) * 8 + wave, (G - rem) * 8);
          else if (!rem) CONVERT_ITEMS(IT_P1_HI, IT_END, gw, NGW); }
    }
    SEAM(5);
    PH_BEGIN(6) {
        pg8::Gemm g{H, Wdn_t, FF, FF, FF, 0, 0}; pg8::StaticOrder S; S.init(M, D, G, (int)blockIdx.x, 1);
        if (fusedfin) { pg8::EpiFinal E{X1B, RSQ, out, g_fin, (float*)(ws + WS_CTL + 65536), (unsigned*)(ws + WS_CTL + 14336), (unsigned*)(ws + WS_CTL) + XB_TMO};
            pg8::gemm_phase<pg8::EpiFinal, false>(lds, g, S, E); }
        else { pg8::EpiRes2 E{out};
            pg8::gemm_phase<pg8::EpiRes2, false>(lds, g, S, E); }
    }
    if (!fusedfin) SEAM(6);
    PH_BEGIN(7) { if (!fusedfin)
        for (int m = gw; m < M; m += NGW) {
            f32x4* xr = (f32x4*)(out + (size_t)m * D) + lane; const f32x4* gr = (const f32x4*)g_fin + lane;
            f32x4 v[8]; float s = 0.f;
#pragma unroll
            for (int j = 0; j < 8; ++j) { v[j] = xr[64 * j]; s += (v[j][0] * v[j][0] + v[j][1] * v[j][1]) + (v[j][2] * v[j][2] + v[j][3] * v[j][3]); }
            const float inv = rsqrtf(wave_sum(s) * (1.f / D) + EPS);
#pragma unroll
            for (int j = 0; j < 8; ++j) { const f32x4 gg = gr[64 * j]; xr[64 * j] = v[j] * inv * gg; }
        }
    }
#undef IN
#undef SEAM
}

extern "C" void kernel_launch(void* const* d_in, const int* in_sizes, int n_in, void* d_out, int out_size, void* d_ws, size_t ws_size, hipStream_t stream) {
    static int grid = 0;
    if (grid == 0) {
        if (n_in != 11 || in_sizes[0] != M * D || out_size != M * D || ws_size < WS_END) { fprintf(stderr, "kernel_launch: unexpected sizes (n_in %d, in0 %d, out %d, ws %zu)\n", n_in, n_in > 0 ? in_sizes[0] : -1, out_size, ws_size); grid = -1; return; }
        int dev = 0, cus = 0, per_cu = 0;
        if (hipGetDevice(&dev) != hipSuccess || hipDeviceGetAttribute(&cus, hipDeviceAttributeMultiprocessorCount, dev) != hipSuccess) { grid = -1; return; }
        if (hipFuncSetAttribute((const void*)fwd_megakernel, hipFuncAttributeMaxDynamicSharedMemorySize, LDS_BYTES) != hipSuccess) { fprintf(stderr, "kernel_launch: hipFuncSetAttribute failed\n"); grid = -1; return; }
        if (hipOccupancyMaxActiveBlocksPerMultiprocessor(&per_cu, (const void*)fwd_megakernel, 512, LDS_BYTES) != hipSuccess || per_cu < 1) { fprintf(stderr, "kernel_launch: occupancy query says %d\n", per_cu); per_cu = 1; }
        (void)hipGetLastError();
        grid = cus * 1;
    }
    if (grid < 0) return;
    (void)hipMemsetAsync((char*)d_ws + WS_CTL, 0, CTL_BYTES, stream);
    Args a{};
    for (int i = 0; i < 11; ++i) a.in[i] = (const float*)d_in[i];
    a.out = (float*)d_out; a.ws = (unsigned char*)d_ws;
#if MK_N_LAUNCHES == 1
    a.ph_lo = 0; a.ph_hi = NPH;
    void* kargs[] = {&a};
    hipError_t e = hipLaunchCooperativeKernel((const void*)fwd_megakernel, dim3(grid), dim3(512), kargs, LDS_BYTES, stream);
    if (e != hipSuccess) fprintf(stderr, "kernel_launch: cooperative launch failed: %s (grid %d)\n", hipGetErrorString(e), grid);
#else
    for (int p = 0; p < NPH; ++p) {
        a.ph_lo = p; a.ph_hi = p + 1;
        hipLaunchKernelGGL(fwd_megakernel, dim3(grid), dim3(512), LDS_BYTES, stream, a);
#ifdef PROBE_DUP
        if (p == PROBE_DUP) hipLaunchKernelGGL(fwd_megakernel, dim3(grid), dim3(512), LDS_BYTES, stream, a);
#endif
    }
#endif
}
```

```cpp
#include <hip/hip_runtime.h>
#include <hip/hip_cooperative_groups.h>
#include <cstdio>
#include <cstdint>
namespace cg = cooperative_groups;

#ifndef MK_N_LAUNCHES
#define MK_N_LAUNCHES 1
#endif

#define LAS __attribute__((address_space(3)))
typedef unsigned short bf16_t;
typedef short bf16x8 __attribute__((ext_vector_type(8)));
typedef short s16x4 __attribute__((ext_vector_type(4)));
typedef float f32x2 __attribute__((ext_vector_type(2)));
typedef float f32x4 __attribute__((ext_vector_type(4)));
typedef float f32x16 __attribute__((ext_vector_type(16)));
typedef unsigned u32x2 __attribute__((ext_vector_type(2)));
typedef unsigned u32x4 __attribute__((ext_vector_type(4)));
typedef __bf16 bfv2 __attribute__((ext_vector_type(2)));

constexpr int M = 8192, D = 2048, INW = 8704, FF = 5632, FF2 = 11264;
constexpr int QA_OFF = 0, KA_OFF = 1024, VA_OFF = 1280, QB_OFF = 1536, KB_OFF = 2560, VB_OFF = 3584, GA_OFF = 4608, GB_OFF = 6656;
constexpr float EPS = 1e-6f, LOG2E = 1.4426950408889634f, QSCALE = 0.125f * LOG2E;
constexpr int NPH = 8;
constexpr size_t MiB = 1u << 20;
constexpr size_t WS_WIN = 0, WS_WAB = 34 * MiB, WS_WOUT = 42 * MiB, WS_WFFN = 50 * MiB, WS_WDN = 94 * MiB;
constexpr size_t WS_XN = 116 * MiB;
constexpr size_t WS_ATT = 148 * MiB;
constexpr size_t WS_PROJ = 180 * MiB;
constexpr size_t WS_RSQ = 316 * MiB, WS_CTL = 317 * MiB, CTL_BYTES = 20480, WS_END = 318 * MiB;
constexpr int OST_OFF = 122880, OST_PITCH = 144, OST_WAVE = 32 * OST_PITCH;
constexpr int LDSCTL_OFF = OST_OFF + 8 * OST_WAVE;
constexpr int LDS_BYTES = LDSCTL_OFF + 1024;

__device__ __forceinline__ unsigned pk2(float lo, float hi) { f32x2 v = {lo, hi}; return __builtin_bit_cast(unsigned, __builtin_convertvector(v, bfv2)); }
__device__ __forceinline__ float bflo(unsigned w) { return __builtin_bit_cast(float, w << 16); }
__device__ __forceinline__ float bfhi(unsigned w) { return __builtin_bit_cast(float, w & 0xffff0000u); }
__device__ __forceinline__ float fsigmoid(float g) { return __builtin_amdgcn_rcpf(1.f + __builtin_amdgcn_exp2f(-g * LOG2E)); }

namespace pg8 {
constexpr int BM = 256, BK = 64, HALF = 128, HTB = HALF * BK * 2, STAGE_BYTES = 8 * HTB, NXCD = 8, WGM = 8;
__device__ __forceinline__ int lds_byte(int r, int c) { const int st = (r >> 4) * 2 + (c >> 5), rr = r & 15, cc = c & 31, ob = rr * 64 + cc * 2; return st * 1024 + (ob ^ (((ob >> 9) & 1) << 5)); }
__device__ __forceinline__ void stage_rc(int b, int& R, int& C) { const int st = b / 1024, sb = b % 1024, swz = sb ^ (((sb >> 9) & 1) << 5); R = (st >> 1) * 16 + swz / 64; C = (st & 1) * 32 + (swz % 64) / 2; }
__device__ __forceinline__ int perm32(int rho) { const int n = rho >> 4, i = rho & 15; return 8 * (i >> 2) + 4 * n + (i & 3); }

struct Unit { int pm, pn, z; };
struct Gemm { const bf16_t* A; const bf16_t* Bt; int lda, ldb, K; size_t zoffA, zoffB; };

struct StaticOrder {
    int nM, nN, nwg, G, c, nz;
    __device__ void init(int M_, int N_, int G_, int c_, int nz_) { nM = M_ / BM; nN = N_ / BM; nwg = nM * nN; G = G_; c = c_; nz = nz_; }
    __device__ bool next(int i, Unit& u) const {
        const int ti = i / nz; u.z = i - ti * nz;
        const long L = (long)ti * G + c; if (L >= nwg) return false;
        int wgid = (int)L; { const int q = nwg / NXCD, r = nwg % NXCD, xcd = wgid % NXCD, off = wgid / NXCD; wgid = (xcd < r ? xcd * (q + 1) : r * (q + 1) + (xcd - r) * q) + off; }
        const int nig = WGM * nN, gid = wgid / nig, fm = gid * WGM, gsz = (nM - fm) < WGM ? (nM - fm) : WGM;
        u.pm = fm + ((wgid % nig) % gsz); u.pn = (wgid % nig) / gsz; return true;
    }
};

#define EPI_ROW(u, ai, m) ((u).pm * 256 + (ai) * 128 + wr * 64 + (m) * 16 + fr)
#define EPI_COL(u, bj) ((u).pn * 256 + (bj) * 128 + wc * 32 + 8 * fq)

struct EpiStoreBf16 {
    static constexpr bool AFTER_DRAIN = false;
    bf16_t* O; int ldc;
    __device__ __forceinline__ void operator()(const f32x4 (&acc)[2][2][4][2], const Unit& u, int wr, int wc, int fr, int fq) const {
#pragma unroll
        for (int ai = 0; ai < 2; ++ai)
#pragma unroll
            for (int m = 0; m < 4; ++m) { bf16_t* rowp = O + (size_t)EPI_ROW(u, ai, m) * ldc;
#pragma unroll
                for (int bj = 0; bj < 2; ++bj) { const f32x4 v0 = acc[ai][bj][m][0], v1 = acc[ai][bj][m][1];
                    u32x4 w; w.x = pk2(v0[0], v0[1]); w.y = pk2(v0[2], v0[3]); w.z = pk2(v1[0], v1[1]); w.w = pk2(v1[2], v1[3]);
                    *(u32x4*)(rowp + EPI_COL(u, bj)) = w; } }
    }
};
struct EpiProj {
    static constexpr bool AFTER_DRAIN = false;
    bf16_t* QKV; bf16_t* Gb;
    __device__ __forceinline__ void operator()(const f32x4 (&acc)[2][2][4][2], const Unit& u, int wr, int wc, int fr, int fq) const {
        const bool isg = u.pn >= 18;
#pragma unroll
        for (int ai = 0; ai < 2; ++ai)
#pragma unroll
            for (int m = 0; m < 4; ++m) { const int r = EPI_ROW(u, ai, m);
#pragma unroll
                for (int bj = 0; bj < 2; ++bj) { const int c = EPI_COL(u, bj); const f32x4 v0 = acc[ai][bj][m][0], v1 = acc[ai][bj][m][1];
                    u32x4 w; w.x = pk2(v0[0], v0[1]); w.y = pk2(v0[2], v0[3]); w.z = pk2(v1[0], v1[1]); w.w = pk2(v1[2], v1[3]);
                    bf16_t* dst = isg ? Gb + (size_t)r * 4096 + (c - GA_OFF) : QKV + ((size_t)(c >> 6) * M + r) * 64 + (c & 63);
                    *(u32x4*)dst = w; } }
    }
};
struct EpiBranch {
    static constexpr bool AFTER_DRAIN = false;
    const bf16_t* Gb; float* T; bf16_t* MRG;
    __device__ __forceinline__ void operator()(const f32x4 (&acc)[2][2][4][2], const Unit& u, int wr, int wc, int fr, int fq) const {
        const int goff = (u.z == 0) ? 0 : 2048;
#pragma unroll
        for (int ai = 0; ai < 2; ++ai) {
            u32x4 gw[4][2], tw[4][2];
#pragma unroll
            for (int m = 0; m < 4; ++m)
#pragma unroll
                for (int bj = 0; bj < 2; ++bj) gw[m][bj] = *(const u32x4*)(Gb + (size_t)EPI_ROW(u, ai, m) * 4096 + goff + EPI_COL(u, bj));
            if (u.z != 0) {
#pragma unroll
                for (int m = 0; m < 4; ++m)
#pragma unroll
                    for (int bj = 0; bj < 2; ++bj) tw[m][bj] = *(const u32x4*)((const bf16_t*)T + (size_t)EPI_ROW(u, ai, m) * D + EPI_COL(u, bj));
            }
#pragma unroll
            for (int m = 0; m < 4; ++m) { const int r = EPI_ROW(u, ai, m);
#pragma unroll
                for (int bj = 0; bj < 2; ++bj) { const int c = EPI_COL(u, bj); const u32x4 g = gw[m][bj];
                    f32x4 v0 = acc[ai][bj][m][0], v1 = acc[ai][bj][m][1];
                    v0[0] *= fsigmoid(bflo(g.x)); v0[1] *= fsigmoid(bfhi(g.x)); v0[2] *= fsigmoid(bflo(g.y)); v0[3] *= fsigmoid(bfhi(g.y));
                    v1[0] *= fsigmoid(bflo(g.z)); v1[1] *= fsigmoid(bfhi(g.z)); v1[2] *= fsigmoid(bflo(g.w)); v1[3] *= fsigmoid(bfhi(g.w));
                    if (u.z != 0) { const u32x4 t = tw[m][bj];
                        v0[0] += bflo(t.x); v0[1] += bfhi(t.x); v0[2] += bflo(t.y); v0[3] += bfhi(t.y); v1[0] += bflo(t.z); v1[1] += bfhi(t.z); v1[2] += bflo(t.w); v1[3] += bfhi(t.w); }
                    u32x4 w; w.x = pk2(v0[0], v0[1]); w.y = pk2(v0[2], v0[3]); w.z = pk2(v1[0], v1[1]); w.w = pk2(v1[2], v1[3]);
                    if (u.z == 0) *(u32x4*)((bf16_t*)T + (size_t)r * D + c) = w;
                    else *(u32x4*)(MRG + (size_t)r * D + c) = w; } }
        }
    }
};
struct EpiRes1 {
    static constexpr bool AFTER_DRAIN = false;
    const float* x; float* x1; bf16_t* x1b; float* rsq; bool write_f32;
    __device__ __forceinline__ void operator()(const f32x4 (&acc)[2][2][4][2], const Unit& u, int wr, int wc, int fr, int fq) const {
#pragma unroll
        for (int ai = 0; ai < 2; ++ai)
#pragma unroll
            for (int m = 0; m < 4; ++m) { const int r = EPI_ROW(u, ai, m); float ss = 0.f;
#pragma unroll
                for (int bj = 0; bj < 2; ++bj) { const int c = EPI_COL(u, bj); const size_t off = (size_t)r * D + c;
                    const f32x4 v0 = acc[ai][bj][m][0] + *(const f32x4*)(x + off), v1 = acc[ai][bj][m][1] + *(const f32x4*)(x + off + 4);
                    if (write_f32) { *(f32x4*)(x1 + off) = v0; *(f32x4*)(x1 + off + 4) = v1; }
                    ss += (v0[0] * v0[0] + v0[1] * v0[1]) + (v0[2] * v0[2] + v0[3] * v0[3]) + (v1[0] * v1[0] + v1[1] * v1[1]) + (v1[2] * v1[2] + v1[3] * v1[3]);
                    u32x4 w; w.x = pk2(v0[0], v0[1]); w.y = pk2(v0[2], v0[3]); w.z = pk2(v1[0], v1[1]); w.w = pk2(v1[2], v1[3]);
                    *(u32x4*)(x1b + off) = w; }
                ss += __shfl_xor(ss, 16); ss += __shfl_xor(ss, 32);
                if (fq == 0) rsq[(size_t)r * 32 + u.pn * 4 + wc] = ss; }
    }
};
struct EpiSwiglu {
    static constexpr bool AFTER_DRAIN = false;
    const float* rsq; bf16_t* H;
    __device__ __forceinline__ void operator()(const f32x4 (&acc)[2][2][4][2], const Unit& u, int wr, int wc, int fr, int fq) const {
#pragma unroll
        for (int ai = 0; ai < 2; ++ai)
#pragma unroll
            for (int m = 0; m < 4; ++m) { const int r = EPI_ROW(u, ai, m);
                const f32x4 p0 = *(const f32x4*)(rsq + (size_t)r * 32 + 8 * fq), p1 = *(const f32x4*)(rsq + (size_t)r * 32 + 8 * fq + 4);
                float s = ((p0[0] + p0[1]) + (p0[2] + p0[3])) + ((p1[0] + p1[1]) + (p1[2] + p1[3]));
                s += __shfl_xor(s, 16); s += __shfl_xor(s, 32);
                const float inv = rsqrtf(s * (1.0f / D) + EPS);
                float h[8];
#pragma unroll
                for (int n = 0; n < 2; ++n)
#pragma unroll
                    for (int j = 0; j < 4; ++j) { const float g = acc[ai][0][m][n][j] * inv, up = acc[ai][1][m][n][j] * inv; h[4 * n + j] = g * fsigmoid(g) * up; }
                u32x4 w; w.x = pk2(h[0], h[1]); w.y = pk2(h[2], h[3]); w.z = pk2(h[4], h[5]); w.w = pk2(h[6], h[7]);
                *(u32x4*)(H + (size_t)r * FF + u.pn * 128 + wc * 32 + 8 * fq) = w; }
    }
};
struct EpiRes2 {
    static constexpr bool AFTER_DRAIN = false;
    float* x;
    __device__ __forceinline__ void operator()(const f32x4 (&acc)[2][2][4][2], const Unit& u, int wr, int wc, int fr, int fq) const {
#pragma unroll
        for (int ai = 0; ai < 2; ++ai)
#pragma unroll
            for (int m = 0; m < 4; ++m) { const int r = EPI_ROW(u, ai, m);
#pragma unroll
                for (int bj = 0; bj < 2; ++bj) { float* p = x + (size_t)r * D + EPI_COL(u, bj);
                    const f32x4 v0 = acc[ai][bj][m][0] + *(const f32x4*)p, v1 = acc[ai][bj][m][1] + *(const f32x4*)(p + 4);
                    *(f32x4*)p = v0; *(f32x4*)(p + 4) = v1; } }
    }
};

__device__ __forceinline__ void panel_exchange(LAS unsigned char* lds, const Unit& u, int wid, int lane, float* xb, unsigned* cnt, unsigned* tmo) {
    LAS float* P = (LAS float*)lds; LAS float* T = (LAS float*)(lds + 4096);
    asm volatile("s_waitcnt lgkmcnt(0)" ::: "memory"); __builtin_amdgcn_s_barrier(); asm volatile("" ::: "memory");
    const int tid = wid * 64 + lane;
    if (tid < 256) {
        const float part = (P[tid * 4 + 0] + P[tid * 4 + 1]) + (P[tid * 4 + 2] + P[tid * 4 + 3]);
        __hip_atomic_store(xb + ((size_t)(u.pm * 256 + tid) * 8 + u.pn), part, __ATOMIC_RELAXED, __HIP_MEMORY_SCOPE_AGENT);
        asm volatile("s_waitcnt vmcnt(0)" ::: "memory");
        if (lane == 0) __hip_atomic_fetch_add(cnt + 16 * u.pm, 1u, __ATOMIC_RELAXED, __HIP_MEMORY_SCOPE_AGENT);
    }
    if (wid == 0) {
        unsigned sp = 0;
        while ((unsigned)__builtin_amdgcn_readfirstlane(__hip_atomic_load(cnt + 16 * u.pm, __ATOMIC_RELAXED, __HIP_MEMORY_SCOPE_AGENT)) < 32u) {
            __builtin_amdgcn_s_sleep(1);
            if ((++sp & 255u) == 0u) { if (__hip_atomic_load(tmo, __ATOMIC_RELAXED, __HIP_MEMORY_SCOPE_AGENT)) break; if (sp > (1u << 18)) { atomicAdd(tmo, 1u); break; } }
        }
        __builtin_amdgcn_fence(__ATOMIC_ACQUIRE, "agent");
    }
    asm volatile("s_waitcnt vmcnt(0) lgkmcnt(0)" ::: "memory"); __builtin_amdgcn_s_barrier(); asm volatile("" ::: "memory");
    if (tid < 256) {
        const float* slot = xb + (size_t)(u.pm * 256 + tid) * 8; float t = 0.f;
#pragma unroll
        for (int k = 0; k < 8; ++k) t += __hip_atomic_load(slot + k, __ATOMIC_RELAXED, __HIP_MEMORY_SCOPE_AGENT);
        T[tid] = t * (1.0f / D) + EPS;
    }
    asm volatile("s_waitcnt lgkmcnt(0)" ::: "memory"); __builtin_amdgcn_s_barrier(); asm volatile("" ::: "memory");
}
#define EPI_SS8(v0, v1) (((v0)[0] * (v0)[0] + (v0)[1] * (v0)[1]) + ((v0)[2] * (v0)[2] + (v0)[3] * (v0)[3]) + ((v1)[0] * (v1)[0] + (v1)[1] * (v1)[1]) + ((v1)[2] * (v1)[2] + (v1)[3] * (v1)[3]))
struct EpiRes1F {
    static constexpr bool AFTER_DRAIN = true;
    const float* x; bf16_t* x1n; float* rms; float* xb; unsigned* cnt; unsigned* tmo;
    __device__ __forceinline__ void fused(f32x4 (&acc)[2][2][4][2], const Unit& u, int wr, int wc, int fr, int fq, LAS unsigned char* lds, int wid, int lane) const {
        LAS float* P = (LAS float*)lds; const LAS float* T = (const LAS float*)(lds + 4096);
#pragma unroll
        for (int ai = 0; ai < 2; ++ai) {
            f32x4 xv[4][2][2];
#pragma unroll
            for (int m = 0; m < 4; ++m)
#pragma unroll
                for (int bj = 0; bj < 2; ++bj) { const float* p = x + (size_t)EPI_ROW(u, ai, m) * D + EPI_COL(u, bj); xv[m][bj][0] = *(const f32x4*)p; xv[m][bj][1] = *(const f32x4*)(p + 4); }
#pragma unroll
            for (int m = 0; m < 4; ++m) { float ss = 0.f;
#pragma unroll
                for (int bj = 0; bj < 2; ++bj) { const f32x4 v0 = acc[ai][bj][m][0] + xv[m][bj][0], v1 = acc[ai][bj][m][1] + xv[m][bj][1];
                    acc[ai][bj][m][0] = v0; acc[ai][bj][m][1] = v1; ss += EPI_SS8(v0, v1); }
                ss += __shfl_xor(ss, 16); ss += __shfl_xor(ss, 32);
                if (fq == 0) P[(ai * 128 + wr * 64 + m * 16 + fr) * 4 + wc] = ss; }
        }
        panel_exchange(lds, u, wid, lane, xb, cnt, tmo);
        const int tid = wid * 64 + lane;
        if (u.pn == 0 && tid < 256) { const float t = T[tid]; rms[u.pm * 256 + tid] = t * rsqrtf(t); }
#pragma unroll
        for (int ai = 0; ai < 2; ++ai)
#pragma unroll
            for (int m = 0; m < 4; ++m) { const int rl = ai * 128 + wr * 64 + m * 16 + fr; const float inv = rsqrtf(T[rl]); const int r = u.pm * 256 + rl;
#pragma unroll
                for (int bj = 0; bj < 2; ++bj) { const f32x4 v0 = acc[ai][bj][m][0] * inv, v1 = acc[ai][bj][m][1] * inv;
                    u32x4 w; w.x = pk2(v0[0], v0[1]); w.y = pk2(v0[2], v0[3]); w.z = pk2(v1[0], v1[1]); w.w = pk2(v1[2], v1[3]);
                    *(u32x4*)(x1n + (size_t)r * D + EPI_COL(u, bj)) = w; } }
    }
};
struct EpiSwigluN {
    static constexpr bool AFTER_DRAIN = false;
    bf16_t* H;
    __device__ __forceinline__ void operator()(const f32x4 (&acc)[2][2][4][2], const Unit& u, int wr, int wc, int fr, int fq) const {
#pragma unroll
        for (int ai = 0; ai < 2; ++ai)
#pragma unroll
            for (int m = 0; m < 4; ++m) { const int r = EPI_ROW(u, ai, m);
                float h[8];
#pragma unroll
                for (int n = 0; n < 2; ++n)
#pragma unroll
                    for (int j = 0; j < 4; ++j) { const float g = acc[ai][0][m][n][j]; h[4 * n + j] = g * fsigmoid(g) * acc[ai][1][m][n][j]; }
                u32x4 w; w.x = pk2(h[0], h[1]); w.y = pk2(h[2], h[3]); w.z = pk2(h[4], h[5]); w.w = pk2(h[6], h[7]);
                *(u32x4*)(H + (size_t)r * FF + u.pn * 128 + wc * 32 + 8 * fq) = w; }
    }
};
struct EpiFinal {
    static constexpr bool AFTER_DRAIN = true;
    const bf16_t* x1n; const float* rms; float* out; const float* gfin; float* xb; unsigned* cnt; unsigned* tmo;
    __device__ __forceinline__ void fused(f32x4 (&acc)[2][2][4][2], const Unit& u, int wr, int wc, int fr, int fq, LAS unsigned char* lds, int wid, int lane) const {
        LAS float* P = (LAS float*)lds; const LAS float* T = (const LAS float*)(lds + 4096);
        u32x4 xw[2][4][2]; float rmv[2][4];
#pragma unroll
        for (int ai = 0; ai < 2; ++ai)
#pragma unroll
            for (int m = 0; m < 4; ++m) { const int r = EPI_ROW(u, ai, m); rmv[ai][m] = rms[r];
#pragma unroll
                for (int bj = 0; bj < 2; ++bj) xw[ai][m][bj] = *(const u32x4*)(x1n + (size_t)r * D + EPI_COL(u, bj)); }
#pragma unroll
        for (int ai = 0; ai < 2; ++ai)
#pragma unroll
            for (int m = 0; m < 4; ++m) { float ss = 0.f; const float rm = rmv[ai][m];
#pragma unroll
                for (int bj = 0; bj < 2; ++bj) { const u32x4 w = xw[ai][m][bj];
                    const f32x4 v0 = acc[ai][bj][m][0] + (f32x4){bflo(w.x), bfhi(w.x), bflo(w.y), bfhi(w.y)} * rm, v1 = acc[ai][bj][m][1] + (f32x4){bflo(w.z), bfhi(w.z), bflo(w.w), bfhi(w.w)} * rm;
                    acc[ai][bj][m][0] = v0; acc[ai][bj][m][1] = v1; ss += EPI_SS8(v0, v1); }
                ss += __shfl_xor(ss, 16); ss += __shfl_xor(ss, 32);
                if (fq == 0) P[(ai * 128 + wr * 64 + m * 16 + fr) * 4 + wc] = ss; }
        f32x4 gg[2][2];
#pragma unroll
        for (int bj = 0; bj < 2; ++bj) { const int c = EPI_COL(u, bj); gg[bj][0] = *(const f32x4*)(gfin + c); gg[bj][1] = *(const f32x4*)(gfin + c + 4); }
        panel_exchange(lds, u, wid, lane, xb, cnt, tmo);
#pragma unroll
        for (int ai = 0; ai < 2; ++ai)
#pragma unroll
            for (int m = 0; m < 4; ++m) { const int rl = ai * 128 + wr * 64 + m * 16 + fr; const float inv = rsqrtf(T[rl]); const int r = u.pm * 256 + rl;
#pragma unroll
                for (int bj = 0; bj < 2; ++bj) { const int c = EPI_COL(u, bj); const f32x4 g0 = gg[bj][0], g1 = gg[bj][1];
                    float* p = out + (size_t)r * D + c;
                    *(f32x4*)p = acc[ai][bj][m][0] * inv * g0; *(f32x4*)(p + 4) = acc[ai][bj][m][1] * inv * g1; } }
    }
};

template <class Epi, bool ALIGN_EPI>
__device__ __forceinline__ void gemm_phase(LAS unsigned char* lds, const Gemm g, const StaticOrder& S, Epi E) {
    const int tid = threadIdx.x, wid = __builtin_amdgcn_readfirstlane(tid >> 6), lane = tid & 63, wr = wid >> 2, wc = wid & 3, fr = lane & 15, fq = lane >> 4;
    const int nt = g.K / BK;
    unsigned voffA[2], voffB[2];
#pragma unroll
    for (int i = 0; i < 2; ++i) { int R, C; stage_rc(tid * 16 + i * 8192, R, C); const int Rb = (R & ~31) + perm32(R & 31);
        voffA[i] = (unsigned)(R * g.lda + C) * 2u; voffB[i] = (unsigned)(Rb * g.ldb + C) * 2u; }
    const size_t kstep = (size_t)(BK * 2);
    const size_t hA = (size_t)HALF * g.lda * 2, hB = (size_t)HALF * g.ldb * 2;
    const size_t tA = 2 * hA, tB = 2 * hB;
    const unsigned ldsw = (unsigned)wid * 1024u;
    const int aoff = lds_byte(wr * 64 + fr, fq * 8), boff = lds_byte(wc * 32 + fr, fq * 8);
#define PG8_SA(b, h) (((b) * 2 + (h)) * HTB)
#define PG8_SB(b, h) ((4 + (b) * 2 + (h)) * HTB)
#define PG8_STAGE(bufoff, gbase, voff) do { _Pragma("unroll") for (int _i = 0; _i < 2; ++_i) \
        __builtin_amdgcn_global_load_lds((const unsigned*)((const char*)(gbase) + (voff)[_i]), (LAS unsigned*)(lds + (bufoff) + ldsw + _i * 8192), 16, 0, 0); } while (0)
#define PG8_LDA(dst, b, h) do { _Pragma("unroll") for (int m = 0; m < 4; ++m) _Pragma("unroll") for (int k = 0; k < 2; ++k) dst[m][k] = *(const LAS bf16x8*)(lds + PG8_SA(b, h) + aoff + m * 2048 + k * 1024); } while (0)
#define PG8_LDB(dst, b, h) do { _Pragma("unroll") for (int n = 0; n < 2; ++n) _Pragma("unroll") for (int k = 0; k < 2; ++k) dst[n][k] = *(const LAS bf16x8*)(lds + PG8_SB(b, h) + boff + n * 2048 + k * 1024); } while (0)
#define PG8_MMA(ai, bj, At, Bt) do { __builtin_amdgcn_s_setprio(1); _Pragma("unroll") for (int m = 0; m < 4; ++m) _Pragma("unroll") for (int n = 0; n < 2; ++n) _Pragma("unroll") for (int k = 0; k < 2; ++k) \
        acc[ai][bj][m][n] = __builtin_amdgcn_mfma_f32_16x16x32_bf16(Bt[n][k], At[m][k], acc[ai][bj][m][n], 0, 0, 0); __builtin_amdgcn_s_setprio(0); } while (0)
#define PG8_WAIT_V(n) asm volatile("s_waitcnt vmcnt(" #n ")" ::: "memory")
#define PG8_WAIT_L(n) asm volatile("s_waitcnt lgkmcnt(" #n ")" ::: "memory")
#define PG8_BAR __builtin_amdgcn_s_barrier()
#define PG8_SCHED __builtin_amdgcn_sched_barrier(0)
    Unit cur, nxt; int ui = 0;
    if (!S.next(0, cur)) return;
    f32x4 acc[2][2][4][2];
#pragma unroll
    for (int a = 0; a < 2; ++a)
#pragma unroll
        for (int b = 0; b < 2; ++b)
#pragma unroll
            for (int m = 0; m < 4; ++m)
#pragma unroll
                for (int n = 0; n < 2; ++n) acc[a][b][m][n] = (f32x4){0.f, 0.f, 0.f, 0.f};
    bf16x8 At[4][2], B0[2][2], B1[2][2];
    const char* cA = (const char*)g.A + (size_t)cur.pm * tA + (size_t)cur.z * g.zoffA; const char* cB = (const char*)g.Bt + (size_t)cur.pn * tB + (size_t)cur.z * g.zoffB;
    PG8_STAGE(PG8_SB(0, 0), cB, voffB); PG8_STAGE(PG8_SB(0, 1), cB + hB, voffB); PG8_STAGE(PG8_SA(0, 0), cA, voffA); PG8_STAGE(PG8_SA(0, 1), cA + hA, voffA);
    if (wr == 1) PG8_BAR;
    PG8_WAIT_V(2); PG8_BAR;
    PG8_STAGE(PG8_SB(1, 0), cB + kstep, voffB); PG8_STAGE(PG8_SA(1, 0), cA + kstep, voffA); PG8_STAGE(PG8_SB(1, 1), cB + hB + kstep, voffB);
    PG8_WAIT_V(6); PG8_BAR;
    for (;;) {
        const bool has_next = S.next(ui + 1, nxt);
        const char* nA = has_next ? (const char*)g.A + (size_t)nxt.pm * tA + (size_t)nxt.z * g.zoffA : cA; const char* nB = has_next ? (const char*)g.Bt + (size_t)nxt.pn * tB + (size_t)nxt.z * g.zoffB : cB;
        for (int t = 0; t < nt; t += 2) {
            const bool last = (t == nt - 2);
            const char* a1 = cA + (size_t)(t + 1) * kstep;
            const char* a2 = last ? nA : cA + (size_t)(t + 2) * kstep; const char* b2 = last ? nB : cB + (size_t)(t + 2) * kstep;
            const char* a3 = a2 + kstep; const char* b3 = b2 + kstep;
            PG8_LDB(B0, 0, 0); PG8_LDB(B1, 0, 1); PG8_SCHED; PG8_LDA(At, 0, 0); PG8_STAGE(PG8_SA(1, 1), a1 + hA, voffA);
            PG8_WAIT_V(8); PG8_WAIT_L(0); PG8_BAR; PG8_MMA(0, 0, At, B0); PG8_MMA(0, 1, At, B1); PG8_BAR; PG8_SCHED;
            PG8_LDA(At, 0, 1); PG8_STAGE(PG8_SB(0, 0), b2, voffB); PG8_STAGE(PG8_SB(0, 1), b2 + hB, voffB); PG8_STAGE(PG8_SA(0, 0), a2, voffA);
            PG8_WAIT_V(8); PG8_WAIT_L(0); PG8_BAR; PG8_MMA(1, 0, At, B0); PG8_MMA(1, 1, At, B1); PG8_BAR; PG8_SCHED;
            PG8_LDB(B0, 1, 0); PG8_LDB(B1, 1, 1); PG8_SCHED; PG8_LDA(At, 1, 0); PG8_STAGE(PG8_SA(0, 1), a2 + hA, voffA);
            PG8_WAIT_V(8); PG8_WAIT_L(0); PG8_BAR; PG8_MMA(0, 0, At, B0); PG8_MMA(0, 1, At, B1); PG8_BAR; PG8_SCHED;
            PG8_LDA(At, 1, 1); PG8_STAGE(PG8_SB(1, 0), b3, voffB); PG8_STAGE(PG8_SB(1, 1), b3 + hB, voffB); PG8_STAGE(PG8_SA(1, 0), a3, voffA);
            PG8_WAIT_V(8); PG8_WAIT_L(0); PG8_BAR; PG8_MMA(1, 0, At, B0); PG8_MMA(1, 1, At, B1); PG8_BAR; PG8_SCHED;
        }
        if constexpr (ALIGN_EPI) { if (wr == 0) PG8_BAR; }
        if constexpr (!Epi::AFTER_DRAIN) E(acc, cur, wr, wc, fr, fq);
        if (!has_next) break;
#pragma unroll
        for (int a = 0; a < 2; ++a)
#pragma unroll
            for (int b = 0; b < 2; ++b)
#pragma unroll
                for (int m = 0; m < 4; ++m)
#pragma unroll
                    for (int n = 0; n < 2; ++n) acc[a][b][m][n] = (f32x4){0.f, 0.f, 0.f, 0.f};
        cur = nxt; cA = nA; cB = nB; ++ui;
        if constexpr (ALIGN_EPI) { if (wr == 1) PG8_BAR; }
    }
    PG8_WAIT_V(0);
    if constexpr (!ALIGN_EPI) { if (wr == 0) PG8_BAR; }
    PG8_BAR;
    if constexpr (Epi::AFTER_DRAIN) E.fused(acc, cur, wr, wc, fr, fq, lds, wid, lane);
#undef PG8_SA
#undef PG8_SB
#undef PG8_STAGE
#undef PG8_LDA
#undef PG8_LDB
#undef PG8_MMA
#undef PG8_WAIT_V
#undef PG8_WAIT_L
#undef PG8_BAR
#undef PG8_SCHED
}
}

#define MFMA32(a, b, c) __builtin_amdgcn_mfma_f32_32x32x16_bf16((a), (b), (c), 0, 0, 0)
constexpr float SB_EXIT = -150.0f;
constexpr int WIN_KEYS = 448;
constexpr int KW_PITCH = 144;
constexpr int VW_PITCH = WIN_KEYS * 2 + 8;
constexpr int VW_OFF = WIN_KEYS * KW_PITCH;
constexpr int ATT_FLAG_OFF = VW_OFF + 64 * VW_PITCH;
static_assert(ATT_FLAG_OFF + 16 <= 131072 && VW_OFF % 16 == 0, "attention LDS map");

struct WinRegs { bf16x8 kv[7]; bf16x8 vv[8]; };
__device__ __forceinline__ void win_issue(WinRegs& w, const bf16_t* Kp, const bf16_t* Vp, int W0, int nk, int tid) {
    const bf16x8* ksrc = (const bf16x8*)(Kp + (size_t)W0 * 64);
#pragma unroll
    for (int i = 0; i < 7; ++i) { const int idx = tid + 512 * i; w.kv[i] = ksrc[idx < nk * 8 ? idx : 0]; }
    const bf16_t* vp = Vp + (size_t)(W0 + (tid < nk ? tid : 0)) * 64;
#pragma unroll
    for (int c = 0; c < 8; ++c) w.vv[c] = *(const bf16x8*)(vp + 8 * c);
}
__device__ __forceinline__ void win_commit(LAS unsigned char* lds, const WinRegs& w, int nk, int tid) {
#pragma unroll
    for (int i = 0; i < 7; ++i) { const int idx = tid + 512 * i; if (idx < nk * 8) *(LAS bf16x8*)(lds + (idx >> 3) * KW_PITCH + 16 * (idx & 7)) = w.kv[i]; }
    if (tid < nk) {
#pragma unroll
        for (int c = 0; c < 8; ++c)
#pragma unroll
            for (int j = 0; j < 8; ++j) *(LAS bf16_t*)(lds + VW_OFF + (8 * c + j) * VW_PITCH + 2 * tid) = (bf16_t)w.vv[c][j];
    }
}
__device__ __forceinline__ f32x16 qk_tile(const LAS unsigned char* lds, int kr0, const bf16x8 (&Bq)[4], int q, int hi) {
    f32x16 S;
#pragma unroll
    for (int i = 0; i < 16; ++i) S[i] = 0.f;
    const LAS unsigned char* kp = lds + (kr0 + q) * KW_PITCH + 16 * hi;
#pragma unroll
    for (int kk = 0; kk < 4; ++kk) S = MFMA32(*(const LAS bf16x8*)(kp + 32 * kk), Bq[kk], S);
    return S;
}
__device__ __forceinline__ void pv_acc(const LAS unsigned char* lds, int kr0, const bf16x8 (&P)[2], f32x16& O0, f32x16& O1, int q, int hi) {
#pragma unroll
    for (int c = 0; c < 2; ++c) {
        const LAS unsigned char* p0 = lds + VW_OFF + q * VW_PITCH + (kr0 + 16 * c + 4 * hi) * 2;
        const LAS unsigned char* p1 = p0 + 32 * VW_PITCH;
        const s16x4 a0 = *(const LAS s16x4*)p0, a1 = *(const LAS s16x4*)(p0 + 16);
        const s16x4 b0 = *(const LAS s16x4*)p1, b1 = *(const LAS s16x4*)(p1 + 16);
        const bf16x8 A0 = {a0[0], a0[1], a0[2], a0[3], a1[0], a1[1], a1[2], a1[3]};
        const bf16x8 A1 = {b0[0], b0[1], b0[2], b0[3], b1[0], b1[1], b1[2], b1[3]};
        O0 = MFMA32(A0, P[c], O0); O1 = MFMA32(A1, P[c], O1);
    }
}
__device__ __forceinline__ void pack_p(const float (&a)[16], bf16x8 (&P)[2]) {
#pragma unroll
    for (int c = 0; c < 2; ++c) { u32x4 w; w.x = pk2(a[8 * c], a[8 * c + 1]); w.y = pk2(a[8 * c + 2], a[8 * c + 3]); w.z = pk2(a[8 * c + 4], a[8 * c + 5]); w.w = pk2(a[8 * c + 6], a[8 * c + 7]);
        P[c] = __builtin_bit_cast(bf16x8, w); }
}
typedef unsigned u32x2s __attribute__((ext_vector_type(2)));
__device__ __forceinline__ void store_o_half(bf16_t* p  , const f32x16& O, float sc, int hi) {
#pragma unroll
    for (int pr = 0; pr < 2; ++pr) { const int ge = 2 * pr, go = 2 * pr + 1;
        const unsigned ex = pk2(O[4 * ge] * sc, O[4 * ge + 1] * sc), ey = pk2(O[4 * ge + 2] * sc, O[4 * ge + 3] * sc);
        const unsigned ox = pk2(O[4 * go] * sc, O[4 * go + 1] * sc), oy = pk2(O[4 * go + 2] * sc, O[4 * go + 3] * sc);
        const u32x2s sx = __builtin_amdgcn_permlane32_swap(ex, ox, false, false), sy = __builtin_amdgcn_permlane32_swap(ey, oy, false, false);
        u32x4 v; v.x = sx.x; v.y = sy.x; v.z = sx.y; v.w = sy.y;
        *(u32x4*)(p + 8 * (2 * pr + hi)) = v; }
}
__device__ __forceinline__ void stage_o_half(LAS unsigned char* st  , const f32x16& O, float sc, int q, int hi) {
#pragma unroll
    for (int pr = 0; pr < 2; ++pr) { const int ge = 2 * pr, go = 2 * pr + 1;
        const unsigned ex = pk2(O[4 * ge] * sc, O[4 * ge + 1] * sc), ey = pk2(O[4 * ge + 2] * sc, O[4 * ge + 3] * sc);
        const unsigned ox = pk2(O[4 * go] * sc, O[4 * go + 1] * sc), oy = pk2(O[4 * go + 2] * sc, O[4 * go + 3] * sc);
        const u32x2s sx = __builtin_amdgcn_permlane32_swap(ex, ox, false, false), sy = __builtin_amdgcn_permlane32_swap(ey, oy, false, false);
        u32x4 v; v.x = sx.x; v.y = sy.x; v.z = sx.y; v.w = sy.y;
        *(LAS u32x4*)(st + q * OST_PITCH + 16 * (2 * pr + hi)) = v; }
}
__device__ __forceinline__ void store_o(LAS unsigned char* lds, int wave, int lane, bf16_t* obase  , const f32x16& O0, const f32x16& O1, float sc) {
    LAS unsigned char* st = lds + OST_OFF + wave * OST_WAVE;
    stage_o_half(st, O0, sc, lane & 31, lane >> 5); stage_o_half(st + 64, O1, sc, lane & 31, lane >> 5);
#pragma unroll
    for (int it = 0; it < 4; ++it) { const int row = 8 * it + (lane >> 3), ch = lane & 7;
        const u32x4 v = *(const LAS u32x4*)(st + row * OST_PITCH + 16 * ch);
        *(u32x4*)(obase + (size_t)row * D + 8 * ch) = v; }
}

template <bool DIAG>
__device__ __forceinline__ void sb_tile(const f32x16& S, int q, int hi, float& carry, float& cl, bf16x8 (&P)[2]) {
    float bt[16], fl[16], a[16];
#pragma unroll
    for (int i = 0; i < 16; ++i) {
        const float y = S[i];
        const float e = __builtin_amdgcn_exp2f(-fabsf(y)), r = __builtin_amdgcn_rcpf(1.f + e), er = e * r;
        const bool pos = y >= 0.f;
        bt[i] = pos ? r : er; fl[i] = pos ? er : r;
        if (DIAG) { const int key = 8 * (i >> 2) + 4 * hi + (i & 3); if (!(key < q)) { bt[i] = 0.f; fl[i] = 1.f; } }
    }
    float g[4], pg[4];
#pragma unroll
    for (int gi = 0; gi < 4; ++gi) { g[gi] = (fl[4 * gi] * fl[4 * gi + 1]) * (fl[4 * gi + 2] * fl[4 * gi + 3]); pg[gi] = __shfl_xor(g[gi], 32); }
    float above = cl, tp = 1.f;
#pragma unroll
    for (int gi = 3; gi >= 0; --gi) {
        const float s3 = above * (hi == 0 ? pg[gi] : 1.f);
        const float s2 = s3 * fl[4 * gi + 3], s1 = s2 * fl[4 * gi + 2], s0 = s1 * fl[4 * gi + 1];
        a[4 * gi + 3] = bt[4 * gi + 3] * s3; a[4 * gi + 2] = bt[4 * gi + 2] * s2; a[4 * gi + 1] = bt[4 * gi + 1] * s1; a[4 * gi + 0] = bt[4 * gi + 0] * s0;
        const float gp = g[gi] * pg[gi];
        above *= gp; tp *= gp;
    }
    cl = above;
    carry += __builtin_amdgcn_logf(tp);
    pack_p(a, P);
}

struct MUnit { int kind, h, QT, reuse; };
__device__ __forceinline__ int munit_w0(const MUnit& u) { const int back = u.kind == 0 ? 192 : 128; const int w = u.QT * 256 - back; return w < 0 ? 0 : w; }
__device__ __forceinline__ const bf16_t* munit_kplane(const bf16_t* QKV, const MUnit& u) { return QKV + (size_t)(u.kind == 0 ? KB_OFF / 64 + u.h : KA_OFF / 64 + (u.h >> 2)) * M * 64; }
__device__ __forceinline__ const bf16_t* munit_vplane(const bf16_t* QKV, const MUnit& u) { return QKV + (size_t)(u.kind == 0 ? VB_OFF / 64 + u.h : VA_OFF / 64 + (u.h >> 2)) * M * 64; }
__device__ __forceinline__ void munit_issue(WinRegs& w, bf16x8 (&Bq)[4], const bf16_t* QKV, const MUnit& u, int wave, int lane) {
    const int W0 = munit_w0(u);
    if (!u.reuse) win_issue(w, munit_kplane(QKV, u), munit_vplane(QKV, u), W0, u.QT * 256 + 256 - W0, wave * 64 + lane);
    const bf16_t* qp = QKV + ((size_t)((u.kind == 0 ? QB_OFF : QA_OFF) / 64 + u.h) * M + u.QT * 256 + 32 * wave + (lane & 31)) * 64 + 8 * (lane >> 5);
#pragma unroll
    for (int kk = 0; kk < 4; ++kk) Bq[kk] = *(const bf16x8*)(qp + 16 * kk);
}

__device__ __forceinline__ void attn_b_compute(LAS unsigned char* lds, const bf16_t* QKV, bf16_t* ATT, const bf16x8 (&Bq)[4], int h, int QT, int wave, int lane) {
    const int q = lane & 31, hi = lane >> 5, T0 = QT * 256, t0 = T0 + 32 * wave;
    f32x16 O0, O1;
#pragma unroll
    for (int i = 0; i < 16; ++i) { O0[i] = 0.f; O1[i] = 0.f; }
    float carry = 0.f, cl = 1.f; bool done = false; int s0 = t0;
    volatile LAS unsigned* flag = (volatile LAS unsigned*)(lds + ATT_FLAG_OFF);
    int Whi = T0 + 256, W0 = T0 - 192 < 0 ? 0 : T0 - 192;
    for (;;) {
        while (!done && s0 >= W0) {
            const f32x16 S = qk_tile(lds, s0 - W0, Bq, q, hi);
            bf16x8 P[2];
            if (s0 == t0) sb_tile<true>(S, q, hi, carry, cl, P); else sb_tile<false>(S, q, hi, carry, cl, P);
            pv_acc(lds, s0 - W0, P, O0, O1, q, hi);
            if (__all(carry < SB_EXIT)) done = true;
            s0 -= 32;
        }
        if (s0 < 0) done = true;
        if (!done && lane == 0) flag[0] = 1u;
        __syncthreads();
        const bool any = flag[0] != 0u;
        if (!any || W0 == 0) break;
        __syncthreads();
        Whi = W0; W0 = W0 - WIN_KEYS < 0 ? 0 : W0 - WIN_KEYS;
        if (threadIdx.x == 0) flag[0] = 0u;
        { WinRegs w; win_issue(w, QKV + (size_t)(KB_OFF / 64 + h) * M * 64, QKV + (size_t)(VB_OFF / 64 + h) * M * 64, W0, Whi - W0, wave * 64 + lane); win_commit(lds, w, Whi - W0, wave * 64 + lane); }
        __syncthreads();
    }
    store_o(lds, wave, lane, ATT + (size_t)t0 * D + 1024 + h * 64, O0, O1, 1.f);
}

__device__ __forceinline__ void attn_a_compute(LAS unsigned char* lds, bf16_t* ATT, const bf16x8 (&Bq)[4], int h, int QT, int wave, int lane, float sink2, float slope2) {
    const int q = lane & 31, hi = lane >> 5, T0 = QT * 256, t0 = T0 + 32 * wave;
    f32x16 O0, O1;
#pragma unroll
    for (int i = 0; i < 16; ++i) { O0[i] = 0.f; O1[i] = 0.f; }
    float mrun = sink2, lrun = 1.f;
    const int W0 = T0 - 128 < 0 ? 0 : T0 - 128;
    for (int s0 = (t0 - 128 < 0 ? 0 : t0 - 128); s0 <= t0; s0 += 32) {
        const f32x16 S = qk_tile(lds, s0 - W0, Bq, q, hi);
        const int dq = t0 - s0 + q;
        float s[16]; float mx = -INFINITY;
#pragma unroll
        for (int i = 0; i < 16; ++i) { const int dist = dq - (8 * (i >> 2) + 4 * hi + (i & 3));
            s[i] = ((unsigned)dist < 128u) ? S[i] - slope2 * (float)dist : -INFINITY; mx = fmaxf(mx, s[i]); }
        mx = fmaxf(mx, __shfl_xor(mx, 32));
        const float mnew = fmaxf(mrun, mx), alpha = __builtin_amdgcn_exp2f(mrun - mnew);
        float a[16]; float rs = 0.f;
#pragma unroll
        for (int i = 0; i < 16; ++i) { a[i] = __builtin_amdgcn_exp2f(s[i] - mnew); rs += a[i]; }
        rs += __shfl_xor(rs, 32);
        lrun = lrun * alpha + rs; mrun = mnew;
#pragma unroll
        for (int i = 0; i < 16; ++i) { O0[i] *= alpha; O1[i] *= alpha; }
        bf16x8 P[2];
        pack_p(a, P);
        pv_acc(lds, s0 - W0, P, O0, O1, q, hi);
    }
    __syncthreads();
    store_o(lds, wave, lane, ATT + (size_t)t0 * D + h * 64, O0, O1, 1.f / lrun);
}

__device__ __forceinline__ bool munit_get(int j, int G, MUnit& u) {
    const int b = (int)blockIdx.x, nper = b < 512 ? (512 - b + G - 1) / G : 0;
    if (j >= 2 * nper) return false;
    const int kind = j >= nper ? 1 : 0, uu = b + (j - kind * nper) * G;
    u.kind = kind; u.h = uu >> 5; u.QT = uu & 31; u.reuse = 0;
    if (kind == 1 && G == 256) { const int jj = j - nper; u.h = 2 * (b >> 5) + jj; u.QT = b & 31; u.reuse = jj; }
    return true;
}
__device__ __forceinline__ void mixer_phase(LAS unsigned char* lds, const bf16_t* QKV, bf16_t* ATT, const float* sinks, int G, int wave, int lane) {
    MUnit cur, nxt;
    if (!munit_get(0, G, cur)) return;
    WinRegs w; bf16x8 Bqn[4];
    munit_issue(w, Bqn, QKV, cur, wave, lane);
    for (int j = 0;; ++j) {
        bf16x8 Bq[4];
#pragma unroll
        for (int kk = 0; kk < 4; ++kk) Bq[kk] = Bqn[kk];
        if (!cur.reuse) {
            win_commit(lds, w, cur.QT * 256 + 256 - munit_w0(cur), wave * 64 + lane);
            if (threadIdx.x == 0) *(volatile LAS unsigned*)(lds + ATT_FLAG_OFF) = 0u;
            __syncthreads();
        }
        const bool has_next = munit_get(j + 1, G, nxt);
        if (has_next) munit_issue(w, Bqn, QKV, nxt, wave, lane);
        if (cur.kind == 0) attn_b_compute(lds, QKV, ATT, Bq, cur.h, cur.QT, wave, lane);
        else attn_a_compute(lds, ATT, Bq, cur.h, cur.QT, wave, lane, sinks[cur.h] * LOG2E, __builtin_amdgcn_exp2f(-0.5f * (float)(cur.h + 1)) * LOG2E);
        if (!has_next) break;
        cur = nxt;
    }
}

__device__ __forceinline__ float wave_sum(float v) {
#pragma unroll
    for (int o = 1; o < 64; o <<= 1) v += __shfl_xor(v, o);
    return v;
}
struct TItem { const float* src; bf16_t* dst; const float* ks; int N, ldT; float cs; };
__device__ __forceinline__ TItem p0_decode(int it, int lane, const float* w_in, const float* w_a, const float* w_b, const float* w_out, const float* w_ffn, const float* w_dn, const float* g_ffn,
                                           bf16_t* Win_t, bf16_t* Wab_t, bf16_t* Wout_t, bf16_t* Wffn_t, bf16_t* Wdn_t) {
    constexpr int I_IN = (D / 64) * (INW / 32), I_AB = (1024 / 64) * (D / 32), I_OUT = (D / 64) * (D / 32), I_FFN = (D / 64) * (FF2 / 32);
    const int g = lane & 7, nq = lane >> 3;
    const float* W; bf16_t* WT; int N, ldT, nb, orow_adj = 0; float cs = 1.f; const float* ks = nullptr; int r = it; int mode = 0;
    if (r < I_IN) { W = w_in; WT = Win_t; N = INW; ldT = D; mode = 1; }
    else if ((r -= I_IN) < I_AB) { W = w_a; WT = Wab_t; N = D; ldT = 1024; }
    else if ((r -= I_AB) < I_AB) { W = w_b; WT = Wab_t + (size_t)D * 1024; N = D; ldT = 1024; }
    else if ((r -= I_AB) < I_OUT) { W = w_out; WT = Wout_t; N = D; ldT = D; }
    else if ((r -= I_OUT) < I_FFN) { W = w_ffn; WT = Wffn_t; N = FF2; ldT = D; mode = 2; ks = g_ffn; }
    else { r -= I_FFN; W = w_dn; WT = Wdn_t; N = D; ldT = FF; }
    nb = N / 32; const int kb = r / nb, n0 = (r - kb * nb) * 32, k0 = kb * 64;
    int orow = n0;
    if (mode == 1) cs = (n0 < 1024 || (n0 >= QB_OFF && n0 < KB_OFF)) ? QSCALE : 1.f;
    if (mode == 2) { const int up = n0 >= FF, nn = up ? n0 - FF : n0; orow = (nn >> 7) * 256 + up * 128 + (nn & 127); }
    (void)orow_adj;
    TItem t; t.src = W + (size_t)(k0 + 8 * g) * N + n0 + 4 * nq; t.dst = WT + (size_t)(orow + 4 * nq) * ldT + k0 + 8 * g; t.ks = ks ? ks + k0 + 8 * g : nullptr; t.N = N; t.ldT = ldT; t.cs = cs;
    return t;
}
__device__ __forceinline__ void p0_load(const TItem& t, f32x4 (&v)[8]) {
#pragma unroll
    for (int kk = 0; kk < 8; ++kk) v[kk] = __builtin_nontemporal_load((const f32x4*)(t.src + (size_t)kk * t.N));
}
__device__ __forceinline__ void p0_store(const TItem& t, const f32x4 (&v)[8]) {
    float sc[8];
    if (t.ks) { const f32x4 a = *(const f32x4*)t.ks, b = *(const f32x4*)(t.ks + 4); sc[0] = a[0]; sc[1] = a[1]; sc[2] = a[2]; sc[3] = a[3]; sc[4] = b[0]; sc[5] = b[1]; sc[6] = b[2]; sc[7] = b[3]; }
    else {
#pragma unroll
        for (int kk = 0; kk < 8; ++kk) sc[kk] = 1.f; }
#pragma unroll
    for (int kk = 0; kk < 8; ++kk) sc[kk] *= t.cs;
#pragma unroll
    for (int j = 0; j < 4; ++j) { u32x4 o; o.x = pk2(v[0][j] * sc[0], v[1][j] * sc[1]); o.y = pk2(v[2][j] * sc[2], v[3][j] * sc[3]); o.z = pk2(v[4][j] * sc[4], v[5][j] * sc[5]); o.w = pk2(v[6][j] * sc[6], v[7][j] * sc[7]);
        *(u32x4*)(t.dst + (size_t)j * t.ldT) = o; }
}
__device__ __forceinline__ void norm_row_load(const float* x, int m, int lane, f32x4 (&v)[8]) {
    const f32x4* xr = (const f32x4*)(x + (size_t)m * D) + lane;
#pragma unroll
    for (int j = 0; j < 8; ++j) v[j] = __builtin_nontemporal_load(xr + 64 * j);
}
__device__ __forceinline__ float norm_row_inv(const f32x4 (&v)[8]) {
    float s = 0.f;
#pragma unroll
    for (int j = 0; j < 8; ++j) s += (v[j][0] * v[j][0] + v[j][1] * v[j][1]) + (v[j][2] * v[j][2] + v[j][3] * v[j][3]);
    return rsqrtf(wave_sum(s) * (1.f / D) + EPS);
}

#define XB_TMO      128
#define XB_XCNT(j)  (256  + 64 * (j))
#define XB_XSUB(j)  (1280 + 64 * (j))
#define XB_XGEN(j)  (2304 + 64 * (j))
#define XB_TOP      3328
#define XB_TOPGEN   3392
#define XCD_BAR_WORDS 3456
#define XB_SPIN_CAP (1u << 18)
__device__ __forceinline__ unsigned xb_ld(unsigned* p)              { return __hip_atomic_load(p, __ATOMIC_RELAXED, __HIP_MEMORY_SCOPE_AGENT); }
__device__ __forceinline__ unsigned xb_add(unsigned* p, unsigned v) { return __hip_atomic_fetch_add(p, v, __ATOMIC_RELAXED, __HIP_MEMORY_SCOPE_AGENT); }
__device__ __forceinline__ unsigned xb_xcc_id() { return (unsigned)__builtin_amdgcn_s_getreg((3 << 11) | 20) & 0xFu; }
#define XB_SPIN(cond, bar) do { unsigned _sp = 0; while (cond) { __builtin_amdgcn_s_sleep(1); \
    if ((++_sp & 255u) == 0u) { if (xb_ld(&(bar)[XB_TMO])) break; if (_sp > XB_SPIN_CAP) { atomicAdd(&(bar)[XB_TMO], 1u); break; } } } } while (0)
struct XcdBarrier { unsigned* bar; unsigned x; volatile LAS unsigned* st; };
__device__ __forceinline__ XcdBarrier xcd_barrier_post(unsigned* bar, volatile LAS unsigned* st) {
    XcdBarrier b; b.bar = bar; b.x = xb_xcc_id(); b.st = st;
    if (threadIdx.x == 0) (void)xb_add(&bar[XB_XCNT(b.x)], 1u);
    return b;
}
__device__ __forceinline__ void xcd_barrier_complete(unsigned* bar, unsigned x, unsigned& nloc, unsigned& nx) {
    const unsigned G = gridDim.x * gridDim.y * gridDim.z;
    unsigned sum, cnt, mine, sp = 0u;
    for (;;) {
        sum = 0u; cnt = 0u; mine = 0u;
#pragma unroll
        for (unsigned j = 0; j < 16; ++j) { const unsigned c = xb_ld(&bar[XB_XCNT(j)]); sum += c; cnt += (c > 0u) ? 1u : 0u; mine = (j == x) ? c : mine; }
        if (sum == G) break;
        __builtin_amdgcn_s_sleep(1);
        if ((++sp & 255u) == 0u) { if (xb_ld(&bar[XB_TMO])) break; if (sp > XB_SPIN_CAP) { atomicAdd(&bar[XB_TMO], 1u); break; } }
    }
    nloc = mine > 0u ? mine : 1u; nx = cnt > 0u ? cnt : 1u;
}
__device__ __forceinline__ void xcd_barrier(const XcdBarrier& b) {
    asm volatile("s_waitcnt vmcnt(0)" ::: "memory");
    __syncthreads();
    if (threadIdx.x == 0) {
        unsigned* bar = b.bar;
        __builtin_amdgcn_s_waitcnt(0);
        unsigned nloc = b.st[0], nx = b.st[1];
        if (nloc == 0u) { xcd_barrier_complete(bar, b.x, nloc, nx); b.st[0] = nloc; b.st[1] = nx; }
        const unsigned old = xb_add(&bar[XB_XSUB(b.x)], 1u);
        const unsigned gen = old / nloc;
        if (old + 1u == (gen + 1u) * nloc) {
            __builtin_amdgcn_fence(__ATOMIC_RELEASE, "agent");
            asm volatile("s_waitcnt vmcnt(0)" ::: "memory");
            const unsigned og = xb_add(&bar[XB_TOP], 1u);
            const unsigned tg = og / nx;
            if (og + 1u == (tg + 1u) * nx) xb_add(&bar[XB_TOPGEN], 1u);
            else XB_SPIN(xb_ld(&bar[XB_TOPGEN]) == tg, bar);
            __builtin_amdgcn_fence(__ATOMIC_ACQUIRE, "agent");
            xb_add(&bar[XB_XGEN(b.x)], 1u);
            asm volatile("s_waitcnt vmcnt(0)" ::: "memory");
        } else {
            XB_SPIN(xb_ld(&bar[XB_XGEN(b.x)]) == gen, bar);
            __builtin_amdgcn_fence(__ATOMIC_ACQUIRE, "agent");
            asm volatile("s_waitcnt vmcnt(0)" ::: "memory");
        }
    }
    __syncthreads();
}

constexpr int I_IN = (D / 64) * (INW / 32), I_AB = (1024 / 64) * (D / 32), I_OUT = (D / 64) * (D / 32), I_FFN = (D / 64) * (FF2 / 32), I_DN = (FF / 64) * (D / 32);
constexpr int IT_P1_LO = I_IN, IT_P1_HI = I_IN + 2 * I_AB + I_OUT + I_FFN, IT_END = IT_P1_HI + I_DN;
#define CONVERT_ITEMS(lo_, hi_, widx_, nw_) do { \
    for (int it = (lo_) + (widx_); it < (hi_); it += 4 * (nw_)) { \
        const bool hasb = it + (nw_) < (hi_), hasc = it + 2 * (nw_) < (hi_), hasd = it + 3 * (nw_) < (hi_); \
        const TItem ta = p0_decode(it, lane, w_in, w_a, w_b, w_out, w_ffn, w_dn, g_ffn, Win_t, Wab_t, Wout_t, Wffn_t, Wdn_t); \
        const TItem tb = p0_decode(hasb ? it + (nw_) : it, lane, w_in, w_a, w_b, w_out, w_ffn, w_dn, g_ffn, Win_t, Wab_t, Wout_t, Wffn_t, Wdn_t); \
        const TItem tc = p0_decode(hasc ? it + 2 * (nw_) : it, lane, w_in, w_a, w_b, w_out, w_ffn, w_dn, g_ffn, Win_t, Wab_t, Wout_t, Wffn_t, Wdn_t); \
        const TItem td = p0_decode(hasd ? it + 3 * (nw_) : it, lane, w_in, w_a, w_b, w_out, w_ffn, w_dn, g_ffn, Win_t, Wab_t, Wout_t, Wffn_t, Wdn_t); \
        f32x4 va[8], vb[8], vc[8], vd[8]; \
        p0_load(ta, va); p0_load(tb, vb); p0_load(tc, vc); p0_load(td, vd); \
        p0_store(ta, va); if (hasb) p0_store(tb, vb); if (hasc) p0_store(tc, vc); if (hasd) p0_store(td, vd); \
    } } while (0)

struct Args { const float* in[11]; float* out; unsigned char* ws; int ph_lo, ph_hi; };

__global__ void __launch_bounds__(512, 2) fwd_megakernel(Args args) {
    extern __shared__ __attribute__((aligned(16))) unsigned char lds_raw[];
    LAS unsigned char* lds = (LAS unsigned char*)lds_raw;
    cg::grid_group grid = cg::this_grid();
    const int tid = threadIdx.x, lane = tid & 63, wave = __builtin_amdgcn_readfirstlane(tid >> 6);
    const int G = gridDim.x, gw = blockIdx.x * 8 + wave, NGW = G * 8;
    const int lo = args.ph_lo, hi = args.ph_hi;
    const bool fusedfin = (G == 256) && (MK_N_LAUNCHES == 1);
    unsigned char* ws = args.ws;
    const float* x = args.in[0]; const float* g_mix = args.in[1]; const float* w_in = args.in[2]; const float* sinks = args.in[3];
    const float* w_a = args.in[4]; const float* w_b = args.in[5]; const float* w_out = args.in[6]; const float* g_ffn = args.in[7];
    const float* w_ffn = args.in[8]; const float* w_dn = args.in[9]; const float* g_fin = args.in[10];
    float* out = args.out;
    bf16_t* Win_t = (bf16_t*)(ws + WS_WIN); bf16_t* Wab_t = (bf16_t*)(ws + WS_WAB); bf16_t* Wout_t = (bf16_t*)(ws + WS_WOUT);
    bf16_t* Wffn_t = (bf16_t*)(ws + WS_WFFN); bf16_t* Wdn_t = (bf16_t*)(ws + WS_WDN);
    bf16_t* XN = (bf16_t*)(ws + WS_XN); bf16_t* MRG = XN; bf16_t* ATT = (bf16_t*)(ws + WS_ATT); bf16_t* X1B = ATT;
    bf16_t* QKV = (bf16_t*)(ws + WS_PROJ); bf16_t* GB = (bf16_t*)(ws + WS_PROJ + 72 * MiB); bf16_t* H = QKV; float* RSQ = (float*)(ws + WS_RSQ);
#define IN(k) (lo <= (k) && (k) < hi)
#ifdef PROBE_PH
#define PH_BEGIN(k) if (IN(k)) for (int rep_ = 0; rep_ < ((k) == PROBE_PH ? 2 : 1); ++rep_, ((k) == PROBE_PH && rep_ == 1) ? xcd_barrier(bar) : (void)0)
#else
#define PH_BEGIN(k) if (IN(k))
#endif
#define SEAM(k) do { if (IN(k) && IN((k) + 1)) xcd_barrier(bar); } while (0)
    if (args.ph_lo < 0) grid.sync();
    if (tid < 8) ((LAS unsigned*)(lds + LDSCTL_OFF))[tid] = 0u;
    __syncthreads();
    const XcdBarrier bar = xcd_barrier_post((unsigned*)(ws + WS_CTL), (volatile LAS unsigned*)(lds + LDSCTL_OFF));

    PH_BEGIN(0) {
        CONVERT_ITEMS(0, I_IN, gw, NGW);
        f32x4 gmix[8];
#pragma unroll
        for (int j = 0; j < 8; ++j) gmix[j] = ((const f32x4*)g_mix + lane)[64 * j];
        for (int m = gw; m < M; m += 2 * NGW) {
            const int m2 = m + NGW;
            const bool has2 = m2 < M;
            f32x4 va[8], vb[8];
            norm_row_load(x, m, lane, va); norm_row_load(x, has2 ? m2 : m, lane, vb);
            const float ia = norm_row_inv(va), ib = norm_row_inv(vb);
            u32x2* oa = (u32x2*)(XN + (size_t)m * D) + lane; u32x2* ob = (u32x2*)(XN + (size_t)m2 * D) + lane;
#pragma unroll
            for (int j = 0; j < 8; ++j) { const f32x4 gg = gmix[j];
                u32x2 w; w.x = pk2(va[j][0] * ia * gg[0], va[j][1] * ia * gg[1]); w.y = pk2(va[j][2] * ia * gg[2], va[j][3] * ia * gg[3]); oa[64 * j] = w;
                if (has2) { u32x2 w2; w2.x = pk2(vb[j][0] * ib * gg[0], vb[j][1] * ib * gg[1]); w2.y = pk2(vb[j][2] * ib * gg[2], vb[j][3] * ib * gg[3]); ob[64 * j] = w2; } }
        }
    }
    SEAM(0);
    PH_BEGIN(1) {
        pg8::Gemm g{XN, Win_t, D, D, D, 0, 0}; pg8::StaticOrder S; S.init(M, INW, G, (int)blockIdx.x, 1);
        pg8::EpiProj E{QKV, GB};
        pg8::gemm_phase<pg8::EpiProj, true>(lds, g, S, E);
        { const int rem = S.nwg % G; if (rem && (int)blockIdx.x >= rem) CONVERT_ITEMS(IT_P1_LO, IT_P1_HI, ((int)blockIdx.x - rem) * 8 + wave, (G - rem) * 8);
          else if (!rem) CONVERT_ITEMS(IT_P1_LO, IT_P1_HI, gw, NGW); }
    }
    SEAM(1);
    PH_BEGIN(2) {
        mixer_phase(lds, QKV, ATT, sinks, G, wave, lane);
    }
    SEAM(2);
    PH_BEGIN(3) {
        pg8::Gemm g{ATT, Wab_t, D, 1024, 1024, (size_t)1024 * 2, (size_t)D * 1024 * 2}; pg8::StaticOrder S; S.init(M, D, G, (int)blockIdx.x, 2);
        pg8::EpiBranch E{GB, out, MRG};
        pg8::gemm_phase<pg8::EpiBranch, true>(lds, g, S, E);
    }
    SEAM(3);
    PH_BEGIN(4) {
        pg8::Gemm g{MRG, Wout_t, D, D, D, 0, 0}; pg8::StaticOrder S; S.init(M, D, G, (int)blockIdx.x, 1);
        if (fusedfin) { pg8::EpiRes1F E{x, X1B, RSQ, (float*)(ws + WS_CTL + 65536 + 262144), (unsigned*)(ws + WS_CTL + 16384), (unsigned*)(ws + WS_CTL) + XB_TMO};
            pg8::gemm_phase<pg8::EpiRes1F, false>(lds, g, S, E); }
        else { pg8::EpiRes1 E{x, out, X1B, RSQ, true};
            pg8::gemm_phase<pg8::EpiRes1, false>(lds, g, S, E); }
    }
    SEAM(4);
    PH_BEGIN(5) {
        pg8::Gemm g{X1B, Wffn_t, D, D, D, 0, 0}; pg8::StaticOrder S; S.init(M, FF2, G, (int)blockIdx.x, 1);
        if (fusedfin) { pg8::EpiSwigluN E{H};
            pg8::gemm_phase<pg8::EpiSwigluN, true>(lds, g, S, E); }
        else { pg8::EpiSwiglu E{RSQ, H};
            pg8::gemm_phase<pg8::EpiSwiglu, true>(lds, g, S, E); }
        { const int rem = S.nwg % G; if (rem && (int)blockIdx.x >= rem) CONVERT_ITEMS(IT_P1_HI, IT_END, ((int)blockIdx.x - rem) * 8 + wave, (G - rem) * 8);
          else if (!rem) CONVERT_ITEMS(IT_P1_HI, IT_END, gw, NGW); }
    }
    SEAM(5);
    PH_BEGIN(6) {
        pg8::Gemm g{H, Wdn_t, FF, FF, FF, 0, 0}; pg8::StaticOrder S; S.init(M, D, G, (int)blockIdx.x, 1);
        if (fusedfin) { pg8::EpiFinal E{X1B, RSQ, out, g_fin, (float*)(ws + WS_CTL + 65536), (unsigned*)(ws + WS_CTL + 14336), (unsigned*)(ws + WS_CTL) + XB_TMO};
            pg8::gemm_phase<pg8::EpiFinal, false>(lds, g, S, E); }
        else { pg8::EpiRes2 E{out};
            pg8::gemm_phase<pg8::EpiRes2, false>(lds, g, S, E); }
    }
    if (!fusedfin) SEAM(6);
    PH_BEGIN(7) { if (!fusedfin)
        for (int m = gw; m < M; m += NGW) {
            f32x4* xr = (f32x4*)(out + (size_t)m * D) + lane; const f32x4* gr = (const f32x4*)g_fin + lane;
            f32x4 v[8]; float s = 0.f;
#pragma unroll
            for (int j = 0; j < 8; ++j) { v[j] = xr[64 * j]; s += (v[j][0] * v[j][0] + v[j][1] * v[j][1]) + (v[j][2] * v[j][2] + v[j][3] * v[j][3]); }
            const float inv = rsqrtf(wave_sum(s) * (1.f / D) + EPS);
#pragma unroll
            for (int j = 0; j < 8; ++j) { const f32x4 gg = gr[64 * j]; xr[64 * j] = v[j] * inv * gg; }
        }
    }
#undef IN
#undef SEAM
}

extern "C" void kernel_launch(void* const* d_in, const int* in_sizes, int n_in, void* d_out, int out_size, void* d_ws, size_t ws_size, hipStream_t stream) {
    static int grid = 0;
    if (grid == 0) {
        if (n_in != 11 || in_sizes[0] != M * D || out_size != M * D || ws_size < WS_END) { fprintf(stderr, "kernel_launch: unexpected sizes (n_in %d, in0 %d, out %d, ws %zu)\n", n_in, n_in > 0 ? in_sizes[0] : -1, out_size, ws_size); grid = -1; return; }
        int dev = 0, cus = 0, per_cu = 0;
        if (hipGetDevice(&dev) != hipSuccess || hipDeviceGetAttribute(&cus, hipDeviceAttributeMultiprocessorCount, dev) != hipSuccess) { grid = -1; return; }
        if (hipFuncSetAttribute((const void*)fwd_megakernel, hipFuncAttributeMaxDynamicSharedMemorySize, LDS_BYTES) != hipSuccess) { fprintf(stderr, "kernel_launch: hipFuncSetAttribute failed\n"); grid = -1; return; }
        if (hipOccupancyMaxActiveBlocksPerMultiprocessor(&per_cu, (const void*)fwd_megakernel, 512, LDS_BYTES) != hipSuccess || per_cu < 1) { fprintf(stderr, "kernel_launch: occupancy query says %d\n", per_cu); per_cu = 1; }
        (void)hipGetLastError();
        grid = cus * 1;
    }
    if (grid < 0) return;
    (void)hipMemsetAsync((char*)d_ws + WS_CTL, 0, CTL_BYTES, stream);
    Args a{};
    for (int i = 0; i < 11; ++i) a.in[i] = (const float*)d_in[i];
    a.out = (float*)d_out; a.ws = (unsigned char*)d_ws;
#if MK_N_LAUNCHES == 1
    a.ph_lo = 0; a.ph_hi = NPH;
    void* kargs[] = {&a};
    hipError_t e = hipLaunchCooperativeKernel((const void*)fwd_megakernel, dim3(grid), dim3(512), kargs, LDS_BYTES, stream);
    if (e != hipSuccess) fprintf(stderr, "kernel_launch: cooperative launch failed: %s (grid %d)\n", hipGetErrorString(e), grid);
#else
    for (int p = 0; p < NPH; ++p) {
        a.ph_lo = p; a.ph_hi = p + 1;
        hipLaunchKernelGGL(fwd_megakernel, dim3(grid), dim3(512), LDS_BYTES, stream, a);
#ifdef PROBE_DUP
        if (p == PROBE_DUP) hipLaunchKernelGGL(fwd_megakernel, dim3(grid), dim3(512), LDS_BYTES, stream, a);
#endif
    }
#endif
}
```
